# Optimizing an MI355X kernel written in HIP

```python
import math
import jax, jax.numpy as jnp
from jax import lax
import numpy as np

D_MODEL = 2048
BATCH = 32
SEQ = 256
DEPTH = 2
DEC_BATCH = 2
DEC_SEQ = 2048
PAST_LEN = 512

GRID_W = 64
N_EVEN = (DEPTH + 1) // 2
N_ODD = DEPTH // 2
CONV_CH = D_MODEL // 2
CONV_W = 31
SSM_CH = D_MODEL // 2
SSM_P = 16
SSM_G = SSM_CH // SSM_P
SSM_N = 64
ATT_H = 16
ATT_DK = 64
ATT_DV = 2 * ATT_DK
D_FF = 4 * D_MODEL
Q_BLOCK = 128
ALPHA = (2 * DEPTH) ** 0.25
BETA = (8 * DEPTH) ** -0.25
LN_EPS = 1e-5
ROPE_BASE = 10000.0

kernel_name = "hybrid_diffusion_conv_s5_diffattn_step"


def layer_norm(x, g, b):
    x32 = x.astype(jnp.float32)
    mu = jnp.mean(x32, axis=-1, keepdims=True)
    var = jnp.mean(jnp.square(x32 - mu), axis=-1, keepdims=True)
    y = (x32 - mu) * lax.rsqrt(var + LN_EPS) * g.astype(jnp.float32) + b.astype(jnp.float32)
    return y.astype(x.dtype)


def modulate(x, shift, scale):
    return x * (1 + scale) + shift


def post_residual(x, y, gate, g, b):
    return layer_norm(ALPHA * x + gate * y, g, b)


def sq_relu_mlp(h, w1, w2):
    return jnp.square(jax.nn.relu(h @ w1)) @ w2


def conformer_conv(a_val, a_gate, w_dw, b_dw, ln_g, ln_b):
    u = a_val * jax.nn.sigmoid(a_gate)
    y = lax.conv_general_dilated(
        u, w_dw[:, None, :].astype(u.dtype), window_strides=(1,),
        padding=[(CONV_W // 2, CONV_W // 2)],
        dimension_numbers=("NWC", "WIO", "NWC"),
        feature_group_count=u.shape[-1]) + b_dw
    return jax.nn.silu(layer_norm(y, ln_g, ln_b))


def s5_discretize(lam_re, lam_im, log_dt, b_re, b_im):
    f32 = jnp.float32
    lam_re, lam_im = lam_re.astype(f32), lam_im.astype(f32)
    dt = jnp.exp(log_dt.astype(f32))[:, None]
    mag = jnp.exp(lam_re * dt)
    lb_re, lb_im = mag * jnp.cos(lam_im * dt), mag * jnp.sin(lam_im * dt)
    den = jnp.square(lam_re) + jnp.square(lam_im)
    coef_re = ((lb_re - 1) * lam_re + lb_im * lam_im) / den
    coef_im = (lb_im * lam_re - (lb_re - 1) * lam_im) / den
    b_re, b_im = b_re.astype(f32), b_im.astype(f32)
    bb_re = coef_re[..., None] * b_re - coef_im[..., None] * b_im
    bb_im = coef_re[..., None] * b_im + coef_im[..., None] * b_re
    return lb_re, lb_im, bb_re, bb_im


def complex_linear_combine(e1, e2):
    a1r, a1i, b1r, b1i = e1
    a2r, a2i, b2r, b2i = e2
    return (a1r * a2r - a1i * a2i, a1r * a2i + a1i * a2r,
            a2r * b1r - a2i * b1i + b2r, a2r * b1i + a2i * b1r + b2i)


def s5_scan(u, h0_re, h0_im, lam_re, lam_im, log_dt, b_re, b_im, c_re, c_im):
    f32 = jnp.float32
    lb_re, lb_im, bb_re, bb_im = s5_discretize(lam_re, lam_im, log_dt, b_re, b_im)
    bu_re = jnp.einsum("blgp,gnp->blgn", u, bb_re)
    bu_im = jnp.einsum("blgp,gnp->blgn", u, bb_im)
    h0_re, h0_im = h0_re.astype(f32), h0_im.astype(f32)
    bu_re = bu_re.at[:, 0].add(lb_re * h0_re - lb_im * h0_im)
    bu_im = bu_im.at[:, 0].add(lb_re * h0_im + lb_im * h0_re)
    a_re = jnp.broadcast_to(lb_re, bu_re.shape)
    a_im = jnp.broadcast_to(lb_im, bu_im.shape)
    _, _, h_re, h_im = lax.associative_scan(
        complex_linear_combine, (a_re, a_im, bu_re, bu_im), axis=1)
    c_re, c_im = c_re.astype(f32), c_im.astype(f32)
    y = jnp.einsum("gpn,blgn->blgp", c_re, h_re) - jnp.einsum("gpn,blgn->blgp", c_im, h_im)
    return y, h_re[:, -1], h_im[:, -1]


def conv_ssm_mixer(h, h0_re, h0_im, w_in, w_dw, b_dw, cln_g, cln_b, lam_re, lam_im,
                   log_dt, b_re, b_im, c_re, c_im, d_skip, w_glu, w_out):
    bsz, L, _ = h.shape
    a_val, a_gate, u = jnp.split(h @ w_in, [CONV_CH, 2 * CONV_CH], axis=-1)
    y_conv = conformer_conv(a_val, a_gate, w_dw, b_dw, cln_g, cln_b)
    u32 = u.astype(jnp.float32)
    ug = u32.reshape(bsz, L, SSM_G, SSM_P)
    y_f, hf_re, hf_im = s5_scan(ug, h0_re[:, 0], h0_im[:, 0], lam_re[0], lam_im[0], log_dt[0],
                                b_re[0], b_im[0], c_re[0], c_im[0])
    y_r, hb_re, hb_im = s5_scan(ug[:, ::-1], h0_re[:, 1], h0_im[:, 1], lam_re[1], lam_im[1],
                                log_dt[1], b_re[1], b_im[1], c_re[1], c_im[1])
    y_s = (y_f + y_r[:, ::-1]).reshape(bsz, L, SSM_CH) + d_skip.astype(jnp.float32) * u32
    y_s = jax.nn.gelu(y_s).astype(h.dtype)
    y_ssm = y_s * jax.nn.sigmoid(y_s @ w_glu)
    out = jnp.concatenate([y_conv, y_ssm], axis=-1) @ w_out
    return out, jnp.stack([hf_re, hb_re], axis=1), jnp.stack([hf_im, hb_im], axis=1)


def rope_axis(seg, pos):
    half = seg.shape[-1] // 2
    freqs = ROPE_BASE ** (-jnp.arange(half, dtype=jnp.float32) / half)
    ang = pos[:, None] * freqs
    cos, sin = jnp.cos(ang), jnp.sin(ang)
    s = seg.astype(jnp.float32)
    s1, s2 = s[..., :half], s[..., half:]
    return jnp.concatenate([s1 * cos - s2 * sin, s1 * sin + s2 * cos], axis=-1).astype(seg.dtype)


def rope_2d(x, rows):
    row = jnp.repeat(jnp.arange(rows, dtype=jnp.float32), GRID_W)
    col = jnp.tile(jnp.arange(GRID_W, dtype=jnp.float32), rows)
    ax = x.shape[-1] // 2
    return jnp.concatenate([rope_axis(x[..., :ax], row), rope_axis(x[..., ax:], col)], axis=-1)


def diff_attn_project(h, w_qkv):
    bsz, L, _ = h.shape
    qk = 2 * ATT_H * ATT_DK
    q, k, v = jnp.split(h @ w_qkv, [qk, 2 * qk], axis=-1)
    q = q.reshape(bsz, L, 2, ATT_H, ATT_DK).transpose(2, 0, 3, 1, 4)
    k = k.reshape(bsz, L, 2, ATT_H, ATT_DK).transpose(2, 0, 3, 1, 4)
    v = v.reshape(bsz, L, ATT_H, ATT_DV).transpose(0, 2, 1, 3)
    return q, k, v


def diff_lambda(lq1, lk1, lq2, lk2, lam_init):
    f32 = jnp.float32
    return (jnp.exp(jnp.sum(lq1.astype(f32) * lk1.astype(f32)))
            - jnp.exp(jnp.sum(lq2.astype(f32) * lk2.astype(f32))) + lam_init)


def diff_attend(q, k, v, lam):
    _, bsz, nh, lq, dk = q.shape
    nb = lq // Q_BLOCK
    qb = q.reshape(2, bsz, nh, nb, Q_BLOCK, dk).transpose(3, 0, 1, 2, 4, 5)
    scale = dk ** -0.5

    def one_block(qblk):
        s = jnp.einsum("mbhqd,mbhkd->mbhqk", qblk, k).astype(jnp.float32) * scale
        p = jax.nn.softmax(s, axis=-1)
        w = (p[0] - lam * p[1]).astype(v.dtype)
        return jnp.einsum("bhqk,bhkd->bhqd", w, v)

    o = lax.map(one_block, qb)
    return o.transpose(1, 2, 0, 3, 4).reshape(bsz, nh, lq, v.shape[-1])


def diff_attn_output(o, subln_g, lam_init, w_out):
    bsz, nh, L, dv = o.shape
    dt = o.dtype
    o32 = o.astype(jnp.float32)
    o32 = o32 * lax.rsqrt(jnp.mean(jnp.square(o32), axis=-1, keepdims=True) + LN_EPS)
    o32 = o32 * subln_g.astype(jnp.float32) * (1.0 - lam_init)
    o = o32.astype(dt).transpose(0, 2, 1, 3).reshape(bsz, L, nh * dv)
    return o @ w_out


def setup_inputs(seed: int = 0) -> dict:
    key = jax.random.key(seed)
    ks = jax.random.split(key, 40)
    f32 = jnp.float32

    def nrm(i, shape, s=1.0):
        return s * jax.random.normal(ks[i], shape, f32)

    lam_im_base = math.pi * jnp.arange(SSM_N, dtype=f32)
    return {
        "x_prompt": nrm(0, (BATCH, SEQ, D_MODEL)),
        "x_sample": nrm(1, (DEC_BATCH, DEC_SEQ, D_MODEL)),
        "state_s5_re": nrm(2, (DEC_BATCH, N_EVEN, 2, SSM_G, SSM_N), 0.3),
        "state_s5_im": nrm(3, (DEC_BATCH, N_EVEN, 2, SSM_G, SSM_N), 0.3),
        "cache_k": nrm(4, (DEC_BATCH, N_ODD, 2, ATT_H, PAST_LEN, ATT_DK)),
        "cache_v": nrm(5, (DEC_BATCH, N_ODD, ATT_H, PAST_LEN, ATT_DV)),
        "c": nrm(6, (DEC_BATCH, D_MODEL)),
        "c_ctx": nrm(7, (D_MODEL,)),
        "w_mod": nrm(8, (DEPTH, D_MODEL, 6 * D_MODEL), D_MODEL ** -0.5),
        "b_mod": nrm(9, (DEPTH, 6 * D_MODEL), 0.01),
        "ln_g": 1.0 + nrm(10, (DEPTH, 2, D_MODEL), 0.01),
        "ln_b": nrm(11, (DEPTH, 2, D_MODEL), 0.01),
        "w_in_ab": nrm(12, (N_EVEN, D_MODEL, 2 * CONV_CH + SSM_CH), D_MODEL ** -0.5),
        "w_dw": nrm(13, (N_EVEN, CONV_W, CONV_CH), CONV_W ** -0.5),
        "b_dw": nrm(14, (N_EVEN, CONV_CH), 0.01),
        "conv_ln_g": 1.0 + nrm(15, (N_EVEN, CONV_CH), 0.01),
        "conv_ln_b": nrm(16, (N_EVEN, CONV_CH), 0.01),
        "s5_lambda_re": -0.5 + nrm(17, (N_EVEN, 2, SSM_G, SSM_N), 0.01),
        "s5_lambda_im": lam_im_base + nrm(18, (N_EVEN, 2, SSM_G, SSM_N), 0.01),
        "s5_log_dt": jax.random.uniform(ks[19], (N_EVEN, 2, SSM_G), f32,
                                        minval=math.log(1e-3), maxval=math.log(1e-1)),
        "s5_b_re": nrm(20, (N_EVEN, 2, SSM_G, SSM_N, SSM_P), (2 * SSM_P) ** -0.5),
        "s5_b_im": nrm(21, (N_EVEN, 2, SSM_G, SSM_N, SSM_P), (2 * SSM_P) ** -0.5),
        "s5_c_re": nrm(22, (N_EVEN, 2, SSM_G, SSM_P, SSM_N), (2 * SSM_N) ** -0.5),
        "s5_c_im": nrm(23, (N_EVEN, 2, SSM_G, SSM_P, SSM_N), (2 * SSM_N) ** -0.5),
        "s5_d": 1.0 + nrm(24, (N_EVEN, SSM_CH), 0.1),
        "w_glu": nrm(25, (N_EVEN, SSM_CH, SSM_CH), SSM_CH ** -0.5),
        "w_out_ab": nrm(26, (N_EVEN, CONV_CH + SSM_CH, D_MODEL), BETA * (CONV_CH + SSM_CH) ** -0.5),
        "w_qkv": nrm(27, (N_ODD, D_MODEL, 4 * ATT_H * ATT_DK + ATT_H * ATT_DV), D_MODEL ** -0.5),
        "lam_q1": nrm(28, (N_ODD, ATT_DK), 0.1),
        "lam_k1": nrm(29, (N_ODD, ATT_DK), 0.1),
        "lam_q2": nrm(30, (N_ODD, ATT_DK), 0.1),
        "lam_k2": nrm(31, (N_ODD, ATT_DK), 0.1),
        "subln_g": 1.0 + nrm(32, (N_ODD, ATT_DV), 0.01),
        "w_out_c": nrm(33, (N_ODD, ATT_H * ATT_DV, D_MODEL), BETA * (ATT_H * ATT_DV) ** -0.5),
        "w_ff1": nrm(34, (DEPTH, D_MODEL, D_FF), D_MODEL ** -0.5),
        "w_ff2": nrm(35, (DEPTH, D_FF, D_MODEL), BETA * D_FF ** -0.5),
    }


def reference(x_prompt, x_sample, state_s5_re, state_s5_im, cache_k, cache_v, c, c_ctx,
              w_mod, b_mod, ln_g, ln_b, w_in_ab, w_dw, b_dw, conv_ln_g, conv_ln_b,
              s5_lambda_re, s5_lambda_im, s5_log_dt, s5_b_re, s5_b_im, s5_c_re, s5_c_im,
              s5_d, w_glu, w_out_ab, w_qkv, lam_q1, lam_k1, lam_q2, lam_k2, subln_g,
              w_out_c, w_ff1, w_ff2):
    silu_ctx = jax.nn.silu(c_ctx)[None, :]
    silu_c = jax.nn.silu(c)
    yp, ys = x_prompt, x_sample
    zero_state = jnp.zeros((x_prompt.shape[0], 2, SSM_G, SSM_N), jnp.float32)
    s_re_list, s_im_list, k_list, v_list = [], [], [], []
    for l in range(DEPTH):
        mod_p = jnp.split((silu_ctx @ w_mod[l] + b_mod[l])[:, None, :], 6, axis=-1)
        mod_s = jnp.split((silu_c @ w_mod[l] + b_mod[l])[:, None, :], 6, axis=-1)
        hp = modulate(yp, mod_p[0], mod_p[1])
        hs = modulate(ys, mod_s[0], mod_s[1])
        if l % 2 == 0:
            e = l // 2
            prm = (w_in_ab[e], w_dw[e], b_dw[e], conv_ln_g[e], conv_ln_b[e],
                   s5_lambda_re[e], s5_lambda_im[e], s5_log_dt[e], s5_b_re[e], s5_b_im[e],
                   s5_c_re[e], s5_c_im[e], s5_d[e], w_glu[e], w_out_ab[e])
            mp, st_re, st_im = conv_ssm_mixer(hp, zero_state, zero_state, *prm)
            ms, _, _ = conv_ssm_mixer(hs, state_s5_re[:, e], state_s5_im[:, e], *prm)
            s_re_list.append(st_re)
            s_im_list.append(st_im)
        else:
            o_i = l // 2
            lam_init = 0.8 - 0.6 * math.exp(-0.3 * l)
            lam = diff_lambda(lam_q1[o_i], lam_k1[o_i], lam_q2[o_i], lam_k2[o_i], lam_init)
            qp, kp, vp = diff_attn_project(hp, w_qkv[o_i])
            mp = diff_attn_output(diff_attend(qp, kp, vp, lam), subln_g[o_i], lam_init, w_out_c[o_i])
            k_list.append(jnp.swapaxes(kp, 0, 1))
            v_list.append(vp)
            qs, ks_, vs = diff_attn_project(hs, w_qkv[o_i])
            rows = hs.shape[1] // GRID_W
            qs = rope_2d(qs, rows)
            ks_ = rope_2d(ks_, rows)
            ck = jnp.swapaxes(cache_k[:, o_i], 0, 1).astype(ks_.dtype)
            ks_ = jnp.concatenate([ks_, ck], axis=3)
            vs = jnp.concatenate([vs, cache_v[:, o_i].astype(vs.dtype)], axis=2)
            ms = diff_attn_output(diff_attend(qs, ks_, vs, lam), subln_g[o_i], lam_init, w_out_c[o_i])
        yp = post_residual(yp, mp, mod_p[2], ln_g[l, 0], ln_b[l, 0])
        ys = post_residual(ys, ms, mod_s[2], ln_g[l, 0], ln_b[l, 0])
        fp = sq_relu_mlp(modulate(yp, mod_p[3], mod_p[4]), w_ff1[l], w_ff2[l])
        fs = sq_relu_mlp(modulate(ys, mod_s[3], mod_s[4]), w_ff1[l], w_ff2[l])
        yp = post_residual(yp, fp, mod_p[5], ln_g[l, 1], ln_b[l, 1])
        ys = post_residual(ys, fs, mod_s[5], ln_g[l, 1], ln_b[l, 1])
    new_state_s5_re = jnp.stack(s_re_list, axis=1)
    new_state_s5_im = jnp.stack(s_im_list, axis=1)
    new_cache_k = jnp.stack(k_list, axis=1)
    new_cache_v = jnp.stack(v_list, axis=1)
    return (yp, ys, new_state_s5_re, new_state_s5_im, new_cache_k, new_cache_v)
```

```cpp
#include <hip/hip_runtime.h>
#include <hip/hip_cooperative_groups.h>
#include <cstdio>
#include <cstdint>
namespace cg = cooperative_groups;
namespace pg8 {
#define PG8_LAS __attribute__((address_space(3)))
typedef unsigned short bf16_t;
typedef short bf16x8 __attribute__((ext_vector_type(8)));
typedef float f32x4 __attribute__((ext_vector_type(4)));
typedef unsigned u32x4 __attribute__((ext_vector_type(4)));
constexpr int BM = 256, BK = 64, HALF = 128, HTB = HALF * BK * 2  , STAGE_BYTES = 8 * HTB, NXCD = 8, WGM = 8;

__host__ __device__ __forceinline__ int lds_byte(int r, int c) { const int st = (r >> 4) * 2 + (c >> 5), rr = r & 15, cc = c & 31, ob = rr * 64 + cc * 2; return st * 1024 + (ob ^ (((ob >> 9) & 1) << 5)); }
__host__ __device__ __forceinline__ void stage_rc(int b, int& R, int& C) { const int st = b / 1024, sb = b % 1024, swz = sb ^ (((sb >> 9) & 1) << 5); R = (st >> 1) * 16 + swz / 64; C = (st & 1) * 32 + (swz % 64) / 2; }
__host__ __device__ __forceinline__ int perm32(int rho) { const int n = rho >> 4, i = rho & 15; return 8 * (i >> 2) + 4 * n + (i & 3); }

struct Unit { int pm, pn; };
struct Gemm { const bf16_t* A; const bf16_t* Bt; int M, N, K; int KS = 0, NT = 0; };

struct StaticOrder {
    int nM, nN, nwg, G, c;
    __host__ __device__ void init(int M, int N, int G_, int c_) { nM = M / BM; nN = N / BM; nwg = nM * nN; G = G_; c = c_; }
    __host__ __device__ bool next(int i, Unit& u) const {
        const long L = (long)i * G + c; if (L >= nwg) return false;
        int wgid = (int)L; { const int q = nwg / NXCD, r = nwg % NXCD, xcd = wgid % NXCD, off = wgid / NXCD; wgid = (xcd < r ? xcd * (q + 1) : r * (q + 1) + (xcd - r) * q) + off; }
        const int nig = WGM * nN, gid = wgid / nig, fm = gid * WGM, gsz = (nM - fm) < WGM ? (nM - fm) : WGM;
        u.pm = fm + ((wgid % nig) % gsz); u.pn = (wgid % nig) / gsz; return true;
    }
    __device__ __forceinline__ void a_ready(const Unit&) const {}
    __device__ __forceinline__ void done(const Unit&) const {}
};

__device__ __forceinline__ unsigned cvt_pk_bf16(float lo, float hi) { unsigned r; asm volatile("v_cvt_pk_bf16_f32 %0, %1, %2" : "=v"(r) : "v"(lo), "v"(hi)); return r; }
typedef float f32x2 __attribute__((ext_vector_type(2)));
template <class Epi, class Sched, bool ALIGN_EPI = false, bool SP2 = false>
__device__ __forceinline__ void gemm_phase(PG8_LAS unsigned char* lds, const Gemm g, const Sched& S, const Epi& E) {
    const int tid = threadIdx.x, wid = __builtin_amdgcn_readfirstlane(tid >> 6), lane = tid & 63, wr = wid >> 2, wc = wid & 3, fr = lane & 15, fq = lane >> 4;
    const int K = g.K, nt = (g.KS ? g.KS : K) / BK;
    const int NTs = g.NT ? g.NT : (1 << 20); const size_t ksl = (size_t)g.KS * 2;
    unsigned voffA[2], voffB[2];
#pragma unroll
    for (int i = 0; i < 2; ++i) { int R, C; stage_rc(tid * 16 + i * 8192, R, C); const int Rb = Epi::PERM ? ((R & ~31) + perm32(R & 31)) : R;
        voffA[i] = (unsigned)(R * K + C) * 2u; voffB[i] = (unsigned)(Rb * K + C) * 2u; }
    const size_t kstep = (size_t)(BK * 2);
    const size_t hstep = (size_t)HALF * K * 2;
    const size_t tstep = 2 * hstep;
    const unsigned ldsw = (unsigned)wid * 1024u;
    const int aoff = lds_byte(wr * 64 + fr, fq * 8), boff = lds_byte(wc * 32 + fr, fq * 8);
#define PG8_SA(b, h) (((b) * 2 + (h)) * HTB)
#define PG8_SB(b, h) ((4 + (b) * 2 + (h)) * HTB)
#define PG8_STAGE(bufoff, gbase, voff) do { _Pragma("unroll") for (int _i = 0; _i < 2; ++_i) \
        __builtin_amdgcn_global_load_lds((const unsigned*)((const char*)(gbase) + (voff)[_i]), (PG8_LAS unsigned*)(lds + (bufoff) + ldsw + _i * 8192), 16, 0, 0); } while (0)
#define PG8_LDA(dst, b, h) do { _Pragma("unroll") for (int m = 0; m < 4; ++m) _Pragma("unroll") for (int k = 0; k < 2; ++k) dst[m][k] = *(const PG8_LAS bf16x8*)(lds + PG8_SA(b, h) + aoff + m * 2048 + k * 1024); } while (0)
#define PG8_LDB(dst, b, h) do { _Pragma("unroll") for (int n = 0; n < 2; ++n) _Pragma("unroll") for (int k = 0; k < 2; ++k) dst[n][k] = *(const PG8_LAS bf16x8*)(lds + PG8_SB(b, h) + boff + n * 2048 + k * 1024); } while (0)
#define PG8_MMA(ai, bj, At, Bt) do { __builtin_amdgcn_s_setprio(1); _Pragma("unroll") for (int m = 0; m < 4; ++m) _Pragma("unroll") for (int n = 0; n < 2; ++n) _Pragma("unroll") for (int k = 0; k < 2; ++k) \
        acc[ai][bj][m][n] = __builtin_amdgcn_mfma_f32_16x16x32_bf16(Bt[n][k], At[m][k], acc[ai][bj][m][n], 0, 0, 0); __builtin_amdgcn_s_setprio(0); } while (0)
#define PG8_WAIT_V(n) asm volatile("s_waitcnt vmcnt(" #n ")" ::: "memory")
#define PG8_WAIT_L(n) asm volatile("s_waitcnt lgkmcnt(" #n ")" ::: "memory")
#define PG8_BAR __builtin_amdgcn_s_barrier()
#define PG8_SCHED __builtin_amdgcn_sched_barrier(0)
    Unit cur, nxt; int ui = 0;
    if (!S.next(0, cur)) return;
    f32x4 acc[2][2][4][2];
#pragma unroll
    for (int a = 0; a < 2; ++a)
#pragma unroll
        for (int b = 0; b < 2; ++b)
#pragma unroll
            for (int m = 0; m < 4; ++m)
#pragma unroll
                for (int n = 0; n < 2; ++n) acc[a][b][m][n] = (f32x4){0.f, 0.f, 0.f, 0.f};
    bf16x8 At[4][2], B0[2][2], B1[2][2];
    const char* cA = (const char*)g.A + (size_t)cur.pm * tstep + (size_t)(cur.pn / NTs) * ksl; const char* cB = (const char*)g.Bt + (size_t)(cur.pn % NTs) * tstep + (size_t)(cur.pn / NTs) * ksl;
    S.a_ready(cur);
    if constexpr (SP2) {
        PG8_STAGE(PG8_SB(0, 0), cB, voffB); PG8_STAGE(PG8_SB(0, 1), cB + hstep, voffB); PG8_STAGE(PG8_SA(0, 0), cA, voffA); PG8_STAGE(PG8_SA(0, 1), cA + hstep, voffA);
        if (wr == 1) PG8_BAR;
        PG8_WAIT_V(2); PG8_BAR;
        PG8_STAGE(PG8_SB(1, 0), cB + kstep, voffB); PG8_STAGE(PG8_SA(1, 0), cA + kstep, voffA); PG8_STAGE(PG8_SB(1, 1), cB + hstep + kstep, voffB);
        PG8_WAIT_V(6); PG8_BAR;
    } else {
        PG8_STAGE(PG8_SB(0, 0), cB, voffB); PG8_STAGE(PG8_SA(0, 0), cA, voffA); PG8_STAGE(PG8_SB(0, 1), cB + hstep, voffB); PG8_STAGE(PG8_SA(0, 1), cA + hstep, voffA);
        if (wr == 1) PG8_BAR;
        PG8_WAIT_V(4); PG8_BAR;
        PG8_STAGE(PG8_SB(1, 0), cB + kstep, voffB); PG8_STAGE(PG8_SA(1, 0), cA + kstep, voffA); PG8_STAGE(PG8_SB(1, 1), cB + hstep + kstep, voffB);
        PG8_WAIT_V(6); PG8_BAR;
    }
    for (;;) {
        const bool has_next = S.next(ui + 1, nxt);
        const char* nA = has_next ? (const char*)g.A + (size_t)nxt.pm * tstep + (size_t)(nxt.pn / NTs) * ksl : cA; const char* nB = has_next ? (const char*)g.Bt + (size_t)(nxt.pn % NTs) * tstep + (size_t)(nxt.pn / NTs) * ksl : cB;
        for (int t = 0; t < nt; t += 2) {
            const bool last = (t == nt - 2);
            const char* a1 = cA + (size_t)(t + 1) * kstep;
            const char* a2 = last ? nA : cA + (size_t)(t + 2) * kstep; const char* b2 = last ? nB : cB + (size_t)(t + 2) * kstep;
            const char* a3 = a2 + kstep; const char* b3 = b2 + kstep;
            if (last && has_next) S.a_ready(nxt);
            if constexpr (SP2) {
            PG8_LDB(B0, 0, 0); PG8_LDB(B1, 0, 1); PG8_SCHED; PG8_LDA(At, 0, 0); PG8_STAGE(PG8_SA(1, 1), a1 + hstep, voffA);
            PG8_WAIT_V(8); PG8_WAIT_L(0); PG8_BAR; PG8_MMA(0, 0, At, B0); PG8_MMA(0, 1, At, B1); PG8_BAR; PG8_SCHED;
            PG8_LDA(At, 0, 1); PG8_STAGE(PG8_SB(0, 0), b2, voffB); PG8_STAGE(PG8_SB(0, 1), b2 + hstep, voffB); PG8_STAGE(PG8_SA(0, 0), a2, voffA);
            PG8_WAIT_V(8); PG8_WAIT_L(0); PG8_BAR; PG8_MMA(1, 0, At, B0); PG8_MMA(1, 1, At, B1); PG8_BAR; PG8_SCHED;
            PG8_LDB(B0, 1, 0); PG8_LDB(B1, 1, 1); PG8_SCHED; PG8_LDA(At, 1, 0); PG8_STAGE(PG8_SA(0, 1), a2 + hstep, voffA);
            PG8_WAIT_V(8); PG8_WAIT_L(0); PG8_BAR; PG8_MMA(0, 0, At, B0); PG8_MMA(0, 1, At, B1); PG8_BAR; PG8_SCHED;
            PG8_LDA(At, 1, 1); PG8_STAGE(PG8_SB(1, 0), b3, voffB); PG8_STAGE(PG8_SB(1, 1), b3 + hstep, voffB); PG8_STAGE(PG8_SA(1, 0), a3, voffA);
            PG8_WAIT_V(8); PG8_WAIT_L(0); PG8_BAR; PG8_MMA(1, 0, At, B0); PG8_MMA(1, 1, At, B1); PG8_BAR; PG8_SCHED;
            } else {
            PG8_LDB(B0, 0, 0); PG8_SCHED; PG8_LDA(At, 0, 0); PG8_STAGE(PG8_SA(1, 1), a1 + hstep, voffA);
            PG8_WAIT_L(8); PG8_BAR; PG8_WAIT_L(0); PG8_MMA(0, 0, At, B0); PG8_BAR; PG8_SCHED;
            PG8_LDB(B1, 0, 1); PG8_STAGE(PG8_SB(0, 0), b2, voffB);
            PG8_BAR; PG8_WAIT_L(0); PG8_MMA(0, 1, At, B1); PG8_BAR;
            PG8_LDA(At, 0, 1); PG8_STAGE(PG8_SA(0, 0), a2, voffA);
            PG8_BAR; PG8_WAIT_L(0); PG8_MMA(1, 0, At, B0); PG8_BAR; PG8_SCHED;
            PG8_STAGE(PG8_SB(0, 1), b2 + hstep, voffB);
            PG8_WAIT_V(6); PG8_BAR; PG8_MMA(1, 1, At, B1); PG8_BAR;
            PG8_LDB(B0, 1, 0); PG8_SCHED; PG8_LDA(At, 1, 0); PG8_STAGE(PG8_SA(0, 1), a2 + hstep, voffA);
            PG8_WAIT_L(8); PG8_BAR; PG8_WAIT_L(0); PG8_MMA(0, 0, At, B0); PG8_BAR; PG8_SCHED;
            PG8_LDB(B1, 1, 1); PG8_STAGE(PG8_SB(1, 0), b3, voffB);
            PG8_BAR; PG8_WAIT_L(0); PG8_MMA(0, 1, At, B1); PG8_BAR;
            PG8_LDA(At, 1, 1); PG8_STAGE(PG8_SA(1, 0), a3, voffA);
            PG8_BAR; PG8_WAIT_L(0); PG8_MMA(1, 0, At, B0); PG8_BAR; PG8_SCHED;
            PG8_STAGE(PG8_SB(1, 1), b3 + hstep, voffB);
            PG8_WAIT_V(6); PG8_BAR; PG8_MMA(1, 1, At, B1); PG8_BAR;
            }
        }
        if constexpr (ALIGN_EPI) { if (wr == 0) PG8_BAR; }
        asm volatile("s_nop 15\n\ts_nop 15" : "+v"(acc[1][1][3][1]), "+v"(acc[1][1][3][0]), "+v"(acc[1][0][3][1]), "+v"(acc[1][1][2][1]));
        if constexpr (!Epi::AFTER_DRAIN) { E(acc, cur, wr, wc, fr, fq); S.done(cur); }
        if (!has_next) break;
#pragma unroll
        for (int a = 0; a < 2; ++a)
#pragma unroll
            for (int b = 0; b < 2; ++b)
#pragma unroll
                for (int m = 0; m < 4; ++m)
#pragma unroll
                    for (int n = 0; n < 2; ++n) acc[a][b][m][n] = (f32x4){0.f, 0.f, 0.f, 0.f};
        cur = nxt; cA = nA; cB = nB; ++ui;
        if constexpr (ALIGN_EPI) { if (wr == 1) PG8_BAR; }
    }
    PG8_WAIT_V(0);
    if constexpr (!ALIGN_EPI) { if (wr == 0) PG8_BAR; }
    PG8_BAR;
    if constexpr (Epi::AFTER_DRAIN) { E.fused(acc, cur, wr, wc, fr, fq, lds, wid, lane); S.done(cur); }
#undef PG8_SA
#undef PG8_SB
#undef PG8_STAGE
#undef PG8_LDA
#undef PG8_LDB
#undef PG8_MMA
#undef PG8_WAIT_V
#undef PG8_WAIT_L
#undef PG8_BAR
#undef PG8_SCHED
}
}


#ifndef MK_MULTI
#define MK_MULTI 0
#endif
#ifndef MK_DIAG
#define MK_DIAG 0
#endif
#ifndef YPERT
#define YPERT 1.0f
#define SPERT 1.0f
#define VPERT 1.0f
#define KPERT 1.0f
#endif
#ifndef MK_DET
#define MK_DET 0
#define DET_PH 17
#define DET_LO MiB
#define DET_HI WS_END
#define DET_NO_OUT 0
#endif
#ifndef MK_BAR
#define MK_BAR 1
#endif

typedef unsigned short bf16;
typedef short bf16x8 __attribute__((ext_vector_type(8)));
typedef float f32x2 __attribute__((ext_vector_type(2)));
typedef float f32x4 __attribute__((ext_vector_type(4)));
typedef float f32x16 __attribute__((ext_vector_type(16)));
typedef unsigned u32x4 __attribute__((ext_vector_type(4)));
typedef unsigned u32x2 __attribute__((ext_vector_type(2)));

constexpr int TR = 12288, TP = 8192, DM = 2048, DFF = 8192, NTHR = 512, NWAVE = 8;
constexpr float LN_EPS = 1e-5f, ALPHA = 1.41421356237f;
constexpr float QSCALE = 0.125f * 1.4426950408889634f;
constexpr size_t OUT_Y = 0, OUT_SRE = 25165824, OUT_SIM = 25427968, OUT_CK = 25690112, OUT_CV = 42467328;
constexpr size_t MiB = 1u << 20;
constexpr size_t WS_MOD = 0, WS_ROPE = 512 * 1024;
constexpr size_t WS_WIN = 2 * MiB, WS_WGLU = 14 * MiB, WS_WOAB = 16 * MiB, WS_WQKV = 24 * MiB, WS_WOC = 48 * MiB, WS_WF1 = 56 * MiB, WS_WF2 = 120 * MiB;
constexpr size_t WS_H = 184 * MiB, WS_F = 232 * MiB, WS_R = 280 * MiB;
constexpr size_t WS_A2 = WS_R;
constexpr size_t WS_UG = WS_R, WS_US = WS_R + 24 * MiB, WS_YF = WS_R + 48 * MiB, WS_YR = WS_R + 96 * MiB, WS_YS = WS_R + 144 * MiB, WS_CAT = WS_R + 168 * MiB;
constexpr size_t WS_QB = WS_R, WS_KP = WS_R + 48 * MiB, WS_VTP = WS_R + 80 * MiB, WS_KS = WS_R + 112 * MiB, WS_VTS = WS_R + 132 * MiB, WS_OA = WS_R + 152 * MiB;
constexpr size_t WS_F2 = WS_R + 216 * MiB;
constexpr size_t WS_END = WS_R + 264 * MiB;
constexpr int LDS_BYTES = 147456;

__device__ __forceinline__ unsigned pk(float lo, float hi) { return pg8::cvt_pk_bf16(lo, hi); }
__device__ __forceinline__ float bflo(unsigned u) { return __uint_as_float(u << 16); }
__device__ __forceinline__ float bfhi(unsigned u) { return __uint_as_float(u & 0xffff0000u); }
__device__ __forceinline__ float sigm(float x) { return __builtin_amdgcn_rcpf(1.f + __expf(-x)); }
__device__ __forceinline__ float wave_sum(float v) {
#pragma unroll
    for (int o = 1; o < 64; o <<= 1) v += __shfl_xor(v, o);
    return v;
}
__device__ __forceinline__ int crow(int r, int hi) { return (r & 3) + 8 * (r >> 2) + 4 * hi; }
#define LDS_FENCE() asm volatile("s_waitcnt lgkmcnt(0)" ::: "memory")
#define VM_DRAIN() asm volatile("s_waitcnt vmcnt(0)" ::: "memory")

namespace pg8 {
template <int RELU2> struct EpiPlain {
    static constexpr bool PERM = true, AFTER_DRAIN = false;
    bf16_t* O; int ldc;
    __device__ __forceinline__ void operator()(const f32x4 (&acc)[2][2][4][2], const Unit& u, int wr, int wc, int fr, int fq) const {
        const int row0 = u.pm * BM + wr * 64 + fr, col0 = u.pn * BM + wc * 32 + 8 * fq;
#pragma unroll
        for (int ai = 0; ai < 2; ++ai)
#pragma unroll
            for (int m = 0; m < 4; ++m) { bf16_t* rowp = O + (size_t)(row0 + ai * HALF + m * 16) * ldc + col0;
#pragma unroll
                for (int bj = 0; bj < 2; ++bj) { f32x4 v0 = acc[ai][bj][m][0], v1 = acc[ai][bj][m][1];
                    if (RELU2) {
#pragma unroll
                        for (int j = 0; j < 4; ++j) { float a = fmaxf(v0[j], 0.f), b = fmaxf(v1[j], 0.f); v0[j] = a * a; v1[j] = b * b; } }
                    u32x4 w; w.x = cvt_pk_bf16(v0[0], v0[1]); w.y = cvt_pk_bf16(v0[2], v0[3]); w.z = cvt_pk_bf16(v1[0], v1[1]); w.w = cvt_pk_bf16(v1[2], v1[3]);
                    *(u32x4*)(rowp + bj * HALF) = w; } }
    }
};
struct EpiSplit {
    static constexpr bool PERM = true, AFTER_DRAIN = false;
    bf16_t* O0; bf16_t* O1;
    __device__ __forceinline__ void operator()(const f32x4 (&acc)[2][2][4][2], const Unit& u, int wr, int wc, int fr, int fq) const {
        const int row0 = u.pm * BM + wr * 64 + fr, col0 = (u.pn & 7) * BM + wc * 32 + 8 * fq; bf16_t* O = (u.pn >> 3) ? O1 : O0;
#pragma unroll
        for (int ai = 0; ai < 2; ++ai)
#pragma unroll
            for (int m = 0; m < 4; ++m) { bf16_t* rowp = O + (size_t)(row0 + ai * HALF + m * 16) * 2048 + col0;
#pragma unroll
                for (int bj = 0; bj < 2; ++bj) { const f32x4 v0 = acc[ai][bj][m][0], v1 = acc[ai][bj][m][1];
                    u32x4 w; w.x = cvt_pk_bf16(v0[0], v0[1]); w.y = cvt_pk_bf16(v0[2], v0[3]); w.z = cvt_pk_bf16(v1[0], v1[1]); w.w = cvt_pk_bf16(v1[2], v1[3]);
                    *(u32x4*)(rowp + bj * HALF) = w; } }
    }
};
struct EpiIn {
    static constexpr bool PERM = true, AFTER_DRAIN = false;
    bf16_t* UG; bf16_t* US;
    __device__ __forceinline__ void operator()(const f32x4 (&acc)[2][2][4][2], const Unit& u, int wr, int wc, int fr, int fq) const {
        const int row0 = u.pm * BM + wr * 64 + fr;
        if (u.pn < 8) {
            const int col0 = u.pn * 128 + wc * 32 + 8 * fq;
#pragma unroll
            for (int ai = 0; ai < 2; ++ai)
#pragma unroll
                for (int m = 0; m < 4; ++m) { f32x4 v0 = acc[ai][0][m][0], v1 = acc[ai][0][m][1], g0 = acc[ai][1][m][0], g1 = acc[ai][1][m][1];
#pragma unroll
                    for (int j = 0; j < 4; ++j) { v0[j] *= sigm(g0[j]); v1[j] *= sigm(g1[j]); }
                    u32x4 w; w.x = cvt_pk_bf16(v0[0], v0[1]); w.y = cvt_pk_bf16(v0[2], v0[3]); w.z = cvt_pk_bf16(v1[0], v1[1]); w.w = cvt_pk_bf16(v1[2], v1[3]);
                    *(u32x4*)(UG + (size_t)(row0 + ai * HALF + m * 16) * 1024 + col0) = w; }
        } else {
            const int col0 = (u.pn - 8) * 256 + wc * 32 + 8 * fq;
#pragma unroll
            for (int ai = 0; ai < 2; ++ai)
#pragma unroll
                for (int m = 0; m < 4; ++m)
#pragma unroll
                    for (int bj = 0; bj < 2; ++bj) { f32x4 v0 = acc[ai][bj][m][0], v1 = acc[ai][bj][m][1];
                        u32x4 w; w.x = cvt_pk_bf16(v0[0], v0[1]); w.y = cvt_pk_bf16(v0[2], v0[3]); w.z = cvt_pk_bf16(v1[0], v1[1]); w.w = cvt_pk_bf16(v1[2], v1[3]);
                        *(u32x4*)(US + (size_t)(row0 + ai * HALF + m * 16) * 1024 + col0 + bj * HALF) = w; }
        }
    }
};
struct EpiGlu {
    static constexpr bool PERM = true, AFTER_DRAIN = false;
    const bf16_t* YS; bf16_t* CAT;
    __device__ __forceinline__ void operator()(const f32x4 (&acc)[2][2][4][2], const Unit& u, int wr, int wc, int fr, int fq) const {
        const int row0 = u.pm * BM + wr * 64 + fr, col0 = u.pn * BM + wc * 32 + 8 * fq;
#pragma unroll
        for (int ai = 0; ai < 2; ++ai) { u32x4 yv[4][2];
#pragma unroll
            for (int m = 0; m < 4; ++m)
#pragma unroll
                for (int bj = 0; bj < 2; ++bj) yv[m][bj] = *(const u32x4*)(YS + (size_t)(row0 + ai * HALF + m * 16) * 1024 + col0 + bj * HALF);
            asm volatile("s_waitcnt vmcnt(0)" ::: "memory");
#pragma unroll
            for (int m = 0; m < 4; ++m) { const size_t row = (size_t)(row0 + ai * HALF + m * 16);
#pragma unroll
                for (int bj = 0; bj < 2; ++bj) { const f32x4 v0 = acc[ai][bj][m][0], v1 = acc[ai][bj][m][1]; const u32x4 y = yv[m][bj];
                    u32x4 w;
                    w.x = cvt_pk_bf16(bflo(y.x) * sigm(v0[0]), bfhi(y.x) * sigm(v0[1])); w.y = cvt_pk_bf16(bflo(y.y) * sigm(v0[2]), bfhi(y.y) * sigm(v0[3]));
                    w.z = cvt_pk_bf16(bflo(y.z) * sigm(v1[0]), bfhi(y.z) * sigm(v1[1])); w.w = cvt_pk_bf16(bflo(y.w) * sigm(v1[2]), bfhi(y.w) * sigm(v1[3]));
                    *(u32x4*)(CAT + row * 2048 + 1024 + col0 + bj * HALF) = w; } } }
    }
};
struct EpiQkv {
    static constexpr bool PERM = true, AFTER_DRAIN = false;
    bf16_t *QB, *KP, *VTP, *KS, *VTS; float *outK, *outV; const f32x2* rope;
    __device__ __forceinline__ void operator()(const f32x4 (&acc)[2][2][4][2], const Unit& u, int wr, int wc, int fr, int fq) const {
        const bool sample = u.pm >= 32; const int row0 = u.pm * BM + wr * 64 + fr;
        if (u.pn < 16) {
            const bool isq = u.pn < 8; const int cbase = (u.pn & 7) * 256 + wc * 32 + 8 * fq;
#pragma unroll
            for (int ai = 0; ai < 2; ++ai)
#pragma unroll
                for (int m = 0; m < 4; ++m) { const int row = row0 + ai * HALF + m * 16; int bb, s;
                    if (sample) { const int rs = row - 8192; bb = rs >> 11; s = rs & 2047; } else { bb = row >> 8; s = row & 255; }
                    f32x2 csv[8];
                    if (sample) { const int pos = (wc & 1) ? (s & 63) : (s >> 6); const f32x2* tb = rope + pos * 16 + 8 * (fq & 1);
#pragma unroll
                        for (int j = 0; j < 8; ++j) csv[j] = tb[j];
                        asm volatile("s_waitcnt vmcnt(0)" ::: "memory"); }
#pragma unroll
                    for (int bj = 0; bj < 2; ++bj) { const int col = cbase + bj * HALF; const int mm = col >> 10, hh = (col >> 6) & 15, d = col & 63;
                        float v[8];
#pragma unroll
                        for (int j = 0; j < 4; ++j) { v[j] = acc[ai][bj][m][0][j]; v[4 + j] = acc[ai][bj][m][1][j]; }
                        if (sample) {
#pragma unroll
                            for (int j = 0; j < 8; ++j) { const f32x2 cs = csv[j]; const float pr = __shfl_xor(v[j], 32); v[j] = v[j] * cs.x + pr * (fq < 2 ? -cs.y : cs.y); } }
                        if (isq) {
                            u32x4 w; w.x = cvt_pk_bf16(v[0] * QSCALE, v[1] * QSCALE); w.y = cvt_pk_bf16(v[2] * QSCALE, v[3] * QSCALE); w.z = cvt_pk_bf16(v[4] * QSCALE, v[5] * QSCALE); w.w = cvt_pk_bf16(v[6] * QSCALE, v[7] * QSCALE);
                            *(u32x4*)(QB + (size_t)row * 2048 + col) = w;
                        } else {
                            u32x4 w; w.x = cvt_pk_bf16(v[0], v[1]); w.y = cvt_pk_bf16(v[2], v[3]); w.z = cvt_pk_bf16(v[4], v[5]); w.w = cvt_pk_bf16(v[6], v[7]);
                            if (sample) { *(u32x4*)(KS + ((size_t)((bb * 2 + mm) * 16 + hh) * 2560 + s) * 64 + d) = w; }
                            else { const size_t o = ((size_t)((bb * 2 + mm) * 16 + hh) * 256 + s) * 64 + d; *(u32x4*)(KP + o) = w;
                                *(f32x4*)(outK + o) = (f32x4){v[0], v[1], v[2], v[3]} * KPERT; *(f32x4*)(outK + o + 4) = (f32x4){v[4], v[5], v[6], v[7]} * KPERT; }
                        } } }
        } else {
            const int cbase = (u.pn - 16) * 256 + wc * 32 + 8 * fq;
#pragma unroll
            for (int ai = 0; ai < 2; ++ai)
#pragma unroll
                for (int m = 0; m < 4; ++m) { const int row = row0 + ai * HALF + m * 16; int bb, s;
                    if (sample) { const int rs = row - 8192; bb = rs >> 11; s = rs & 2047; } else { bb = row >> 8; s = row & 255; }
#pragma unroll
                    for (int bj = 0; bj < 2; ++bj) { const int col = cbase + bj * HALF; const int hh = col >> 7, dv = col & 127;
                        float v[8];
#pragma unroll
                        for (int j = 0; j < 4; ++j) { v[j] = acc[ai][bj][m][0][j]; v[4 + j] = acc[ai][bj][m][1][j]; }
                        if (sample) { bf16_t* vt = VTS + ((size_t)(bb * 16 + hh) * 128 + dv) * 2560 + s;
#pragma unroll
                            for (int j = 0; j < 8; ++j) vt[(size_t)j * 2560] = (bf16_t)cvt_pk_bf16(v[j], 0.f);
                        } else { bf16_t* vt = VTP + ((size_t)(bb * 16 + hh) * 128 + dv) * 256 + s;
#pragma unroll
                            for (int j = 0; j < 8; ++j) vt[(size_t)j * 256] = (bf16_t)cvt_pk_bf16(v[j], 0.f);
                            const size_t o = ((size_t)(bb * 16 + hh) * 256 + s) * 128 + dv;
                            *(f32x4*)(outV + o) = (f32x4){v[0], v[1], v[2], v[3]} * VPERT; *(f32x4*)(outV + o + 4) = (f32x4){v[4], v[5], v[6], v[7]} * VPERT; }
                    } }
        }
    }
};
}

struct Args { const float* in[36]; float* out; unsigned char* ws; int ph_lo, ph_hi; };
enum { I_XP = 0, I_XS, I_SRE, I_SIM, I_CK, I_CV, I_C, I_CCTX, I_WMOD, I_BMOD, I_LNG, I_LNB, I_WIN, I_WDW, I_BDW, I_CLNG, I_CLNB, I_LRE, I_LIM, I_LDT, I_BRE, I_BIM, I_CRE, I_CIM,
       I_S5D, I_WGLU, I_WOAB, I_WQKV, I_LQ1, I_LK1, I_LQ2, I_LK2, I_SUBG, I_WOC, I_WF1, I_WF2 };

__device__ __forceinline__ void transpose_item(const float* src, int N, int k0, int n0, bf16* dst, size_t dp, int drow0, int dcol0, float* scr, int lane, const float* kscale = nullptr, float kmul = 1.f) {
#pragma unroll 8
    for (int i = 0; i < 32; ++i) { const int kk = 2 * i + (lane >> 5); float v = src[(size_t)(k0 + kk) * N + n0 + (lane & 31)]; if (kscale) v *= kscale[(k0 + kk) & 127] * kmul; scr[kk * 33 + (lane & 31)] = v; }
    VM_DRAIN(); LDS_FENCE();
    const int c = lane & 7;
#pragma unroll
    for (int j = 0; j < 4; ++j) { const int n = (lane >> 3) + 8 * j; const float* s = scr + (8 * c) * 33 + n;
        u32x4 o; o.x = pk(s[0 * 33], s[1 * 33]); o.y = pk(s[2 * 33], s[3 * 33]); o.z = pk(s[4 * 33], s[5 * 33]); o.w = pk(s[6 * 33], s[7 * 33]);
        *(u32x4*)(dst + (size_t)(drow0 + n) * dp + dcol0 + 8 * c) = o; }
    LDS_FENCE();
}
__device__ __forceinline__ void wt_item(const float* W, int K, int N, bf16* WT, bool glu, int item, float* scr, int lane, const float* kscale = nullptr, float kmul = 1.f) {
    const int nblk = N / 32, kb = item / nblk, nb = item % nblk, k0 = 64 * kb, n0 = 32 * nb;
    int d0 = n0;
    if (glu) { if (n0 < 1024) d0 = (n0 >> 7) * 256 + (n0 & 127); else if (n0 < 2048) { const int n1 = n0 - 1024; d0 = (n1 >> 7) * 256 + 128 + (n1 & 127); } }
    transpose_item(W, N, k0, n0, WT, (size_t)K, d0, k0, scr, lane, kscale, kmul);
}
__device__ __forceinline__ void p0_prep(const Args& a, unsigned char* lds, int bid, int G) {
    const int tid = threadIdx.x, lane = tid & 63, wave = tid >> 6;
    float* silu = (float*)lds;
    float* red = (float*)(lds + 98304);
    float* scr = (float*)(lds + 24576 + wave * 8704);
    float* MOD = (float*)(a.ws + WS_MOD);
    if (bid == 0) { f32x2* tab = (f32x2*)(a.ws + WS_ROPE);
        for (int e = tid; e < 1024; e += NTHR) { const int pos = e >> 4, i = e & 15; const float fr = powf(10000.f, -(float)i / 16.f); float sn, cs; sincosf((float)pos * fr, &sn, &cs); tab[e] = (f32x2){cs, sn}; } }
    bool have_silu = false;
    for (int unit = bid; unit < 384; unit += G) {
        if (!have_silu) { for (int e = tid; e < 3 * 2048; e += NTHR) { const int g = e >> 11, k = e & 2047; const float x = g == 0 ? a.in[I_CCTX][k] : a.in[I_C][(g - 1) * 2048 + k]; silu[e] = x * sigm(x); } have_silu = true; __syncthreads(); }
        const int l = unit / 192, cb = unit % 192, q = lane >> 4, li = lane & 15, ks = wave * 4 + q;
        const float* W = a.in[I_WMOD] + (size_t)l * 2048 * 12288 + cb * 64 + li * 4;
        f32x4 a0 = {0.f, 0.f, 0.f, 0.f}, a1 = a0, a2 = a0;
#pragma unroll 8
        for (int i = 0; i < 64; ++i) { const int k = ks + 32 * i; const f32x4 w = *(const f32x4*)(W + (size_t)k * 12288);
            a0 += w * silu[k]; a1 += w * silu[2048 + k]; a2 += w * silu[4096 + k]; }
        *(f32x4*)(red + ks * 192 + li * 4) = a0; *(f32x4*)(red + ks * 192 + 64 + li * 4) = a1; *(f32x4*)(red + ks * 192 + 128 + li * 4) = a2;
        __syncthreads();
        if (tid < 192) { float s = 0.f;
#pragma unroll 8
            for (int k = 0; k < 32; ++k) s += red[k * 192 + tid];
            const int grp = tid >> 6, col = cb * 64 + (tid & 63); MOD[(size_t)(l * 3 + grp) * 12288 + col] = s + a.in[I_BMOD][l * 12288 + col]; }
        __syncthreads();
    }
    const int gw = bid * NWAVE + wave, NGW = G * NWAVE;
    constexpr int I0 = 32 * 96, I1 = 16 * 32, I2 = 32 * 64, I3 = 32 * 192, I4 = 32 * 64, I5 = 32 * 256, I6 = 128 * 64;
    constexpr int NIT = I0 + I1 + I2 + I3 + I4 + 2 * I5 + 2 * I6;
#ifndef P0_NO_WT
#ifndef WT_LIMIT
#define WT_LIMIT NIT
#endif
#ifndef WT_START
#define WT_START 0
#endif
    for (int it = WT_START + gw; it < WT_LIMIT; it += NGW) { int r = it;
        if (r < I0) { wt_item(a.in[I_WIN], 2048, 3072, (bf16*)(a.ws + WS_WIN), true, r, scr, lane); continue; } r -= I0;
        if (r < I1) { wt_item(a.in[I_WGLU], 1024, 1024, (bf16*)(a.ws + WS_WGLU), false, r, scr, lane); continue; } r -= I1;
        if (r < I2) { wt_item(a.in[I_WOAB], 2048, 2048, (bf16*)(a.ws + WS_WOAB), false, r, scr, lane); continue; } r -= I2;
        if (r < I3) { wt_item(a.in[I_WQKV], 2048, 6144, (bf16*)(a.ws + WS_WQKV), false, r, scr, lane); continue; } r -= I3;
        if (r < I4) { wt_item(a.in[I_WOC], 2048, 2048, (bf16*)(a.ws + WS_WOC), false, r, scr, lane, a.in[I_SUBG], 1.f - (0.8f - 0.6f * expf(-0.3f))); continue; } r -= I4;
        if (r < I5) { wt_item(a.in[I_WF1], 2048, 8192, (bf16*)(a.ws + WS_WF1), false, r, scr, lane); continue; } r -= I5;
        if (r < I5) { wt_item(a.in[I_WF1] + (size_t)2048 * 8192, 2048, 8192, (bf16*)(a.ws + WS_WF1 + (size_t)2048 * 8192 * 2), false, r, scr, lane); continue; } r -= I5;
        if (r < I6) { wt_item(a.in[I_WF2], 8192, 2048, (bf16*)(a.ws + WS_WF2), false, r, scr, lane); continue; } r -= I6;
        if (r < I6) { wt_item(a.in[I_WF2] + (size_t)2048 * 8192, 8192, 2048, (bf16*)(a.ws + WS_WF2 + (size_t)2048 * 8192 * 2), false, r, scr, lane); }
    }
#endif
}

__device__ __forceinline__ int row_grp(int row) { return row < TP ? 0 : 1 + ((row - TP) >> 11); }
__device__ __forceinline__ void p_mod_in(const Args& a, int bid, int G) {
    const int lane = threadIdx.x & 63, wave = threadIdx.x >> 6; const int gw = bid * NWAVE + wave, NGW = G * NWAVE;
    const float* MOD = (const float*)(a.ws + WS_MOD); bf16* H = (bf16*)(a.ws + WS_H);
    for (int row = gw; row < TR; row += NGW) {
        const float* x = row < TP ? a.in[I_XP] + (size_t)row * DM : a.in[I_XS] + (size_t)(row - TP) * DM;
        const float* md = MOD + (size_t)row_grp(row) * 12288;
        f32x4 xv[8], shv[8], scv[8];
#pragma unroll
        for (int j = 0; j < 8; ++j) { const int c = j * 256 + lane * 4; xv[j] = *(const f32x4*)(x + c); shv[j] = *(const f32x4*)(md + c); scv[j] = *(const f32x4*)(md + 2048 + c); }
        VM_DRAIN();
#pragma unroll
        for (int j = 0; j < 8; ++j) { const int c = j * 256 + lane * 4; const f32x4 o = xv[j] * (scv[j] + 1.f) + shv[j]; u32x2 w; w.x = pk(o[0], o[1]); w.y = pk(o[2], o[3]); *(u32x2*)(H + (size_t)row * DM + c) = w; }
    }
}
__device__ __forceinline__ void p_ln(const Args& a, int bid, int G, bool xin_first, const float* gate_base  , const float* lng, const float* lnb,
                                     const float* nxt_base  ) {
    const int lane = threadIdx.x & 63, wave = threadIdx.x >> 6; const int gw = bid * NWAVE + wave, NGW = G * NWAVE;
    const bf16* F = (const bf16*)(a.ws + WS_F); const bf16* F2 = (const bf16*)(a.ws + WS_F2); bf16* H = (bf16*)(a.ws + WS_H); float* Y = a.out + OUT_Y;
    for (int row = gw; row < TR; row += NGW) {
        const float* x = xin_first ? (row < TP ? a.in[I_XP] + (size_t)row * DM : a.in[I_XS] + (size_t)(row - TP) * DM) : Y + (size_t)row * DM;
        const int grp = row_grp(row); const float* gt = gate_base + (size_t)grp * 12288;
        f32x4 z[8]; float s = 0.f;
#pragma unroll
        for (int j = 0; j < 8; ++j) { const int c = j * 256 + lane * 4; const f32x4 v = *(const f32x4*)(x + c), g = *(const f32x4*)(gt + c); const u32x2 f = *(const u32x2*)(F + (size_t)row * DM + c), f2 = *(const u32x2*)(F2 + (size_t)row * DM + c);
            f32x4 o; o[0] = ALPHA * v[0] + g[0] * (bflo(f.x) + bflo(f2.x)); o[1] = ALPHA * v[1] + g[1] * (bfhi(f.x) + bfhi(f2.x)); o[2] = ALPHA * v[2] + g[2] * (bflo(f.y) + bflo(f2.y)); o[3] = ALPHA * v[3] + g[3] * (bfhi(f.y) + bfhi(f2.y));
            z[j] = o; s += (o[0] + o[1]) + (o[2] + o[3]); }
        VM_DRAIN();
        const float mean = wave_sum(s) * (1.f / DM); float s2 = 0.f;
#pragma unroll
        for (int j = 0; j < 8; ++j) { z[j] = z[j] - mean; s2 += (z[j][0] * z[j][0] + z[j][1] * z[j][1]) + (z[j][2] * z[j][2] + z[j][3] * z[j][3]); }
        const float rstd = 1.f / sqrtf(wave_sum(s2) * (1.f / DM) + LN_EPS);
#pragma unroll
        for (int hh = 0; hh < 2; ++hh) {
            f32x4 gv[4], bv[4], shv[4], scv[4];
#pragma unroll
            for (int jj = 0; jj < 4; ++jj) { const int c = (hh * 4 + jj) * 256 + lane * 4; gv[jj] = *(const f32x4*)(lng + c); bv[jj] = *(const f32x4*)(lnb + c);
                if (nxt_base) { const float* nb = nxt_base + (size_t)grp * 12288; shv[jj] = *(const f32x4*)(nb + c); scv[jj] = *(const f32x4*)(nb + 2048 + c); } }
            VM_DRAIN();
#pragma unroll
            for (int jj = 0; jj < 4; ++jj) { const int j = hh * 4 + jj, c = j * 256 + lane * 4;
                f32x4 y = z[j] * rstd * gv[jj] + bv[jj]; if (!nxt_base) y = y * YPERT; *(f32x4*)(Y + (size_t)row * DM + c) = y;
                if (nxt_base) { const f32x4 o = y * (scv[jj] + 1.f) + shv[jj]; u32x2 w; w.x = pk(o[0], o[1]); w.y = pk(o[2], o[3]); *(u32x2*)(H + (size_t)row * DM + c) = w; } }
        }
    }
}

__device__ __forceinline__ float gelu_tanh(float x) { const float u = 0.7978845608028654f * (x + 0.044715f * x * x * x); const float e = __expf(2.f * u); const float t = 1.f - 2.f * __builtin_amdgcn_rcpf(e + 1.f); return 0.5f * x * (1.f + t); }
__device__ __forceinline__ void s5_item(const Args& a, unsigned char* wl, bool sample, int b, int g, int dir, int lane) {
    const int L = sample ? 2048 : 256, row0 = sample ? TP + b * 2048 : b * 256, fr = lane & 15, fq = lane >> 4;
    const bf16* US = (const bf16*)(a.ws + WS_US); float* Yo = (float*)(a.ws + (dir ? WS_YR : WS_YF));
    unsigned char* BU = wl; unsigned char* Hl = wl + 8448;
    const int pg = (dir * 64 + g) * 64;
    const float dt = expf(a.in[I_LDT][dir * 64 + g]);
    float lbr, lbi;
    { const float lre = a.in[I_LRE][pg + lane], lim = a.in[I_LIM][pg + lane]; const float mag = expf(lre * dt); float sn, cs; sincosf(lim * dt, &sn, &cs); lbr = mag * cs; lbi = mag * sn; }
    bf16x8 bbop[8];
#pragma unroll
    for (int t = 0; t < 8; ++t) { const int n = 8 * t + (fr >> 1), c = fr & 1;
        const float lre = a.in[I_LRE][pg + n], lim = a.in[I_LIM][pg + n]; const float mag = expf(lre * dt); float sn, cs; sincosf(lim * dt, &sn, &cs);
        const float br = mag * cs, bi = mag * sn, den = 1.f / (lre * lre + lim * lim);
        const float cr = ((br - 1.f) * lre + bi * lim) * den, ci = (bi * lre - (br - 1.f) * lim) * den;
        const float* pbr = a.in[I_BRE] + (size_t)(pg + n) * 16 + 8 * (fq & 1); const float* pbi = a.in[I_BIM] + (size_t)(pg + n) * 16 + 8 * (fq & 1);
        const f32x4 r0 = *(const f32x4*)pbr, r1 = *(const f32x4*)(pbr + 4), i0 = *(const f32x4*)pbi, i1 = *(const f32x4*)(pbi + 4);
        float v[8];
#pragma unroll
        for (int j = 0; j < 4; ++j) { v[j] = c == 0 ? cr * r0[j] - ci * i0[j] : cr * i0[j] + ci * r0[j]; v[4 + j] = c == 0 ? cr * r1[j] - ci * i1[j] : cr * i1[j] + ci * r1[j]; }
        unsigned w[4];
#pragma unroll
        for (int j = 0; j < 4; ++j) { const unsigned h2 = pk(v[2 * j], v[2 * j + 1]); const unsigned l2 = pk(v[2 * j] - bflo(h2), v[2 * j + 1] - bfhi(h2)); w[j] = fq < 2 ? h2 : l2; }
        bbop[t] = __builtin_bit_cast(bf16x8, (u32x4){w[0], w[1], w[2], w[3]}); }
    bf16x8 cmop[4];
#pragma unroll
    for (int s = 0; s < 4; ++s) { const int n0 = 16 * s + 4 * fq; const size_t o = (size_t)((dir * 64 + g) * 16 + fr) * 64 + n0;
        const f32x4 cr = *(const f32x4*)(a.in[I_CRE] + o), ci = *(const f32x4*)(a.in[I_CIM] + o);
        cmop[s] = __builtin_bit_cast(bf16x8, (u32x4){pk(cr[0], -ci[0]), pk(cr[1], -ci[1]), pk(cr[2], -ci[2]), pk(cr[3], -ci[3])}); }
    float hr = 0.f, hi_ = 0.f;
    if (sample) { const size_t o = (size_t)((b * 2 + dir) * 64 + g) * 64 + lane; hr = a.in[I_SRE][o]; hi_ = a.in[I_SIM][o]; }
    const int nch = L / 16;
#define MFMA_PAD4(a0, a1, a2, a3) asm volatile("s_nop 15\n\ts_nop 15" : "+v"(a0), "+v"(a1), "+v"(a2), "+v"(a3))
#define S5_ULOAD(C) (*(const u32x4*)(US + (size_t)(row0 + (dir ? L - 1 - 16 * (C) - fr : 16 * (C) + fr)) * 1024 + g * 16 + 8 * (fq & 1)))
#define S5_YSTORE(C) do { _Pragma("unroll") for (int i = 0; i < 4; ++i) { const int ti = 4 * fq + i; const int tk = dir ? L - 1 - 16 * (C) - ti : 16 * (C) + ti; Yo[(size_t)(row0 + tk) * 1024 + g * 16 + fr] = yprev[i]; } } while (0)
#define S5_CHUNK(C, UCUR, UNEXT) do { const int c = (C); \
        VM_DRAIN();                                     \
        if (c > 0) S5_YSTORE(c - 1);                    \
        if (c + 1 < nch) UNEXT = S5_ULOAD(c + 1); \
        const bf16x8 ua = __builtin_bit_cast(bf16x8, UCUR); f32x4 acc[8]; \
        _Pragma("unroll") for (int t = 0; t < 8; ++t) { acc[t] = (f32x4){0.f, 0.f, 0.f, 0.f}; acc[t] = __builtin_amdgcn_mfma_f32_16x16x32_bf16(ua, bbop[t], acc[t], 0, 0, 0); } \
        MFMA_PAD4(acc[0], acc[1], acc[2], acc[3]); MFMA_PAD4(acc[4], acc[5], acc[6], acc[7]); \
        _Pragma("unroll") for (int t = 0; t < 8; ++t) \
            _Pragma("unroll") for (int i = 0; i < 4; ++i) *(float*)(BU + (4 * fq + i) * 528 + (16 * t + fr) * 4) = acc[t][i]; \
        LDS_FENCE(); \
        f32x2 buv[16];                                  \
        _Pragma("unroll") for (int i = 0; i < 16; ++i) buv[i] = *(const f32x2*)(BU + i * 528 + lane * 8); \
        LDS_FENCE(); \
        _Pragma("unroll") for (int i = 0; i < 16; ++i) { \
            float t0, t1, nr, ni; \
            asm volatile("v_fma_f32 %0, -%5, %7, %8\n\tv_fma_f32 %1, %5, %6, %9\n\tv_fma_f32 %2, %4, %6, %0\n\tv_fma_f32 %3, %4, %7, %1" \
                         : "=&v"(t0), "=&v"(t1), "=&v"(nr), "=&v"(ni) : "v"(lbr), "v"(lbi), "v"(hr), "v"(hi_), "v"(buv[i].x), "v"(buv[i].y)); \
            hr = nr; hi_ = ni; \
            *(unsigned*)(Hl + i * 272 + lane * 4) = pk(hr, hi_); } \
        LDS_FENCE(); \
        f32x4 y = {0.f, 0.f, 0.f, 0.f}; \
        _Pragma("unroll") for (int s = 0; s < 4; ++s) { const bf16x8 ha = *(const bf16x8*)(Hl + fr * 272 + 64 * s + 16 * fq); y = __builtin_amdgcn_mfma_f32_16x16x32_bf16(ha, cmop[s], y, 0, 0, 0); } \
        asm volatile("s_nop 15\n\ts_nop 15" : "+v"(y)); \
        yprev = y; \
        LDS_FENCE(); } while (0)
    f32x4 yprev = {0.f, 0.f, 0.f, 0.f};
    u32x4 uA = S5_ULOAD(0), uB = uA;
    for (int c2 = 0; c2 < nch; c2 += 2) { S5_CHUNK(c2, uA, uB); S5_CHUNK(c2 + 1, uB, uA); }
    S5_YSTORE(nch - 1);
#undef S5_YSTORE
#undef S5_CHUNK
#undef S5_ULOAD
    if (!sample) { const size_t o = (size_t)((b * 2 + dir) * 64 + g) * 64 + lane; a.out[OUT_SRE + o] = hr * SPERT; a.out[OUT_SIM + o] = hi_ * SPERT; }
}
__device__ __forceinline__ void s5_block(const Args& a, unsigned char* lds, bool sample, int task) {
    const int tid = threadIdx.x, lane = tid & 63, wave = tid >> 6;
    const int pi = task * 4 + (wave >> 1), b = pi >> 6, g = pi & 63;
    s5_item(a, lds + wave * 12800, sample, b, g, wave & 1, lane);
    __threadfence(); __syncthreads();
    const int L = sample ? 2048 : 256; const float* YF = (const float*)(a.ws + WS_YF); const float* YR = (const float*)(a.ws + WS_YR); const bf16* US = (const bf16*)(a.ws + WS_US); bf16* YS = (bf16*)(a.ws + WS_YS);
    for (int e0 = tid; e0 < 4 * L * 4; e0 += 4 * NTHR) {
        f32x4 f[4], r[4], dsk[4]; u32x2 uu[4]; size_t oo[4];
#pragma unroll
        for (int k = 0; k < 4; ++k) { const int e = e0 + k * NTHR; const int q = e & 3, t = (e >> 2) % L, pp = (e >> 2) / L; const int pj = task * 4 + pp, bb = pj >> 6, gg = pj & 63;
            const size_t o = (size_t)((sample ? TP + bb * 2048 : bb * 256) + t) * 1024 + gg * 16 + q * 4; oo[k] = o;
            f[k] = *(const f32x4*)(YF + o); r[k] = *(const f32x4*)(YR + o); dsk[k] = *(const f32x4*)(a.in[I_S5D] + gg * 16 + q * 4); uu[k] = *(const u32x2*)(US + o); }
        VM_DRAIN();
#pragma unroll
        for (int k = 0; k < 4; ++k) {
            const float v0 = gelu_tanh(f[k][0] + r[k][0] + dsk[k][0] * bflo(uu[k].x)), v1 = gelu_tanh(f[k][1] + r[k][1] + dsk[k][1] * bfhi(uu[k].x)), v2 = gelu_tanh(f[k][2] + r[k][2] + dsk[k][2] * bflo(uu[k].y)), v3 = gelu_tanh(f[k][3] + r[k][3] + dsk[k][3] * bfhi(uu[k].y));
            u32x2 w; w.x = pk(v0, v1); w.y = pk(v2, v3); *(u32x2*)(YS + oo[k]) = w; }
    }
    __syncthreads();
}
__device__ __forceinline__ void conv_tile(const Args& a, unsigned char* lds, int tile) {
    const int tid = threadIdx.x, lane = tid & 63; const int r0 = tile * 32; int s0, s1;
    if (r0 < TP) { s0 = r0 & ~255; s1 = s0 + 256; } else { s0 = TP + ((r0 - TP) & ~2047); s1 = s0 + 2048; }
    const bf16* UG = (const bf16*)(a.ws + WS_UG); bf16* CAT = (bf16*)(a.ws + WS_CAT); const int c = tid * 2;
    float* part = (float*)lds;
    float* stat = (float*)(lds + 32 * 520 * 4);
    unsigned* lin = (unsigned*)lds;
#pragma unroll 8
    for (int r = 0; r < 62; ++r) { const int row = r0 - 15 + r; unsigned u = 0u; if (row >= s0 && row < s1) u = *(const unsigned*)(UG + (size_t)row * 1024 + c); lin[r * 512 + tid] = u; }
    f32x2 w[31];
#pragma unroll
    for (int k = 0; k < 31; ++k) w[k] = *(const f32x2*)(a.in[I_WDW] + k * 1024 + c);
    const f32x2 bias = *(const f32x2*)(a.in[I_BDW] + c);
    f32x2 acc[32];
#pragma unroll
    for (int t = 0; t < 32; ++t) acc[t] = bias;
    LDS_FENCE();
    const unsigned* lin0 = lin + tid; const unsigned* lin1 = lin + 31 * 512 + tid;
    { const unsigned u = lin0[0 * 512]; f32x2 v; v.x = bflo(u); v.y = bfhi(u); acc[0] += w[0] * v; }
    { const unsigned u = lin0[1 * 512]; f32x2 v; v.x = bflo(u); v.y = bfhi(u); acc[1] += w[0] * v; acc[0] += w[1] * v; }
    asm volatile("" ::: "memory");
    { const unsigned u = lin0[2 * 512]; f32x2 v; v.x = bflo(u); v.y = bfhi(u); acc[2] += w[0] * v; acc[1] += w[1] * v; acc[0] += w[2] * v; }
    { const unsigned u = lin0[3 * 512]; f32x2 v; v.x = bflo(u); v.y = bfhi(u); acc[3] += w[0] * v; acc[2] += w[1] * v; acc[1] += w[2] * v; acc[0] += w[3] * v; }
    asm volatile("" ::: "memory");
    { const unsigned u = lin0[4 * 512]; f32x2 v; v.x = bflo(u); v.y = bfhi(u); acc[4] += w[0] * v; acc[3] += w[1] * v; acc[2] += w[2] * v; acc[1] += w[3] * v; acc[0] += w[4] * v; }
    { const unsigned u = lin0[5 * 512]; f32x2 v; v.x = bflo(u); v.y = bfhi(u); acc[5] += w[0] * v; acc[4] += w[1] * v; acc[3] += w[2] * v; acc[2] += w[3] * v; acc[1] += w[4] * v; acc[0] += w[5] * v; }
    asm volatile("" ::: "memory");
    { const unsigned u = lin0[6 * 512]; f32x2 v; v.x = bflo(u); v.y = bfhi(u); acc[6] += w[0] * v; acc[5] += w[1] * v; acc[4] += w[2] * v; acc[3] += w[3] * v; acc[2] += w[4] * v; acc[1] += w[5] * v; acc[0] += w[6] * v; }
    { const unsigned u = lin0[7 * 512]; f32x2 v; v.x = bflo(u); v.y = bfhi(u); acc[7] += w[0] * v; acc[6] += w[1] * v; acc[5] += w[2] * v; acc[4] += w[3] * v; acc[3] += w[4] * v; acc[2] += w[5] * v; acc[1] += w[6] * v; acc[0] += w[7] * v; }
    asm volatile("" ::: "memory");
    { const unsigned u = lin0[8 * 512]; f32x2 v; v.x = bflo(u); v.y = bfhi(u); acc[8] += w[0] * v; acc[7] += w[1] * v; acc[6] += w[2] * v; acc[5] += w[3] * v; acc[4] += w[4] * v; acc[3] += w[5] * v; acc[2] += w[6] * v; acc[1] += w[7] * v; acc[0] += w[8] * v; }
    { const unsigned u = lin0[9 * 512]; f32x2 v; v.x = bflo(u); v.y = bfhi(u); acc[9] += w[0] * v; acc[8] += w[1] * v; acc[7] += w[2] * v; acc[6] += w[3] * v; acc[5] += w[4] * v; acc[4] += w[5] * v; acc[3] += w[6] * v; acc[2] += w[7] * v; acc[1] += w[8] * v; acc[0] += w[9] * v; }
    asm volatile("" ::: "memory");
    { const unsigned u = lin0[10 * 512]; f32x2 v; v.x = bflo(u); v.y = bfhi(u); acc[10] += w[0] * v; acc[9] += w[1] * v; acc[8] += w[2] * v; acc[7] += w[3] * v; acc[6] += w[4] * v; acc[5] += w[5] * v; acc[4] += w[6] * v; acc[3] += w[7] * v; acc[2] += w[8] * v; acc[1] += w[9] * v; acc[0] += w[10] * v; }
    { const unsigned u = lin0[11 * 512]; f32x2 v; v.x = bflo(u); v.y = bfhi(u); acc[11] += w[0] * v; acc[10] += w[1] * v; acc[9] += w[2] * v; acc[8] += w[3] * v; acc[7] += w[4] * v; acc[6] += w[5] * v; acc[5] += w[6] * v; acc[4] += w[7] * v; acc[3] += w[8] * v; acc[2] += w[9] * v; acc[1] += w[10] * v; acc[0] += w[11] * v; }
    asm volatile("" ::: "memory");
    { const unsigned u = lin0[12 * 512]; f32x2 v; v.x = bflo(u); v.y = bfhi(u); acc[12] += w[0] * v; acc[11] += w[1] * v; acc[10] += w[2] * v; acc[9] += w[3] * v; acc[8] += w[4] * v; acc[7] += w[5] * v; acc[6] += w[6] * v; acc[5] += w[7] * v; acc[4] += w[8] * v; acc[3] += w[9] * v; acc[2] += w[10] * v; acc[1] += w[11] * v; acc[0] += w[12] * v; }
    { const unsigned u = lin0[13 * 512]; f32x2 v; v.x = bflo(u); v.y = bfhi(u); acc[13] += w[0] * v; acc[12] += w[1] * v; acc[11] += w[2] * v; acc[10] += w[3] * v; acc[9] += w[4] * v; acc[8] += w[5] * v; acc[7] += w[6] * v; acc[6] += w[7] * v; acc[5] += w[8] * v; acc[4] += w[9] * v; acc[3] += w[10] * v; acc[2] += w[11] * v; acc[1] += w[12] * v; acc[0] += w[13] * v; }
    asm volatile("" ::: "memory");
    { const unsigned u = lin0[14 * 512]; f32x2 v; v.x = bflo(u); v.y = bfhi(u); acc[14] += w[0] * v; acc[13] += w[1] * v; acc[12] += w[2] * v; acc[11] += w[3] * v; acc[10] += w[4] * v; acc[9] += w[5] * v; acc[8] += w[6] * v; acc[7] += w[7] * v; acc[6] += w[8] * v; acc[5] += w[9] * v; acc[4] += w[10] * v; acc[3] += w[11] * v; acc[2] += w[12] * v; acc[1] += w[13] * v; acc[0] += w[14] * v; }
    { const unsigned u = lin0[15 * 512]; f32x2 v; v.x = bflo(u); v.y = bfhi(u); acc[15] += w[0] * v; acc[14] += w[1] * v; acc[13] += w[2] * v; acc[12] += w[3] * v; acc[11] += w[4] * v; acc[10] += w[5] * v; acc[9] += w[6] * v; acc[8] += w[7] * v; acc[7] += w[8] * v; acc[6] += w[9] * v; acc[5] += w[10] * v; acc[4] += w[11] * v; acc[3] += w[12] * v; acc[2] += w[13] * v; acc[1] += w[14] * v; acc[0] += w[15] * v; }
    asm volatile("" ::: "memory");
    { const unsigned u = lin0[16 * 512]; f32x2 v; v.x = bflo(u); v.y = bfhi(u); acc[16] += w[0] * v; acc[15] += w[1] * v; acc[14] += w[2] * v; acc[13] += w[3] * v; acc[12] += w[4] * v; acc[11] += w[5] * v; acc[10] += w[6] * v; acc[9] += w[7] * v; acc[8] += w[8] * v; acc[7] += w[9] * v; acc[6] += w[10] * v; acc[5] += w[11] * v; acc[4] += w[12] * v; acc[3] += w[13] * v; acc[2] += w[14] * v; acc[1] += w[15] * v; acc[0] += w[16] * v; }
    { const unsigned u = lin0[17 * 512]; f32x2 v; v.x = bflo(u); v.y = bfhi(u); acc[17] += w[0] * v; acc[16] += w[1] * v; acc[15] += w[2] * v; acc[14] += w[3] * v; acc[13] += w[4] * v; acc[12] += w[5] * v; acc[11] += w[6] * v; acc[10] += w[7] * v; acc[9] += w[8] * v; acc[8] += w[9] * v; acc[7] += w[10] * v; acc[6] += w[11] * v; acc[5] += w[12] * v; acc[4] += w[13] * v; acc[3] += w[14] * v; acc[2] += w[15] * v; acc[1] += w[16] * v; acc[0] += w[17] * v; }
    asm volatile("" ::: "memory");
    { const unsigned u = lin0[18 * 512]; f32x2 v; v.x = bflo(u); v.y = bfhi(u); acc[18] += w[0] * v; acc[17] += w[1] * v; acc[16] += w[2] * v; acc[15] += w[3] * v; acc[14] += w[4] * v; acc[13] += w[5] * v; acc[12] += w[6] * v; acc[11] += w[7] * v; acc[10] += w[8] * v; acc[9] += w[9] * v; acc[8] += w[10] * v; acc[7] += w[11] * v; acc[6] += w[12] * v; acc[5] += w[13] * v; acc[4] += w[14] * v; acc[3] += w[15] * v; acc[2] += w[16] * v; acc[1] += w[17] * v; acc[0] += w[18] * v; }
    { const unsigned u = lin0[19 * 512]; f32x2 v; v.x = bflo(u); v.y = bfhi(u); acc[19] += w[0] * v; acc[18] += w[1] * v; acc[17] += w[2] * v; acc[16] += w[3] * v; acc[15] += w[4] * v; acc[14] += w[5] * v; acc[13] += w[6] * v; acc[12] += w[7] * v; acc[11] += w[8] * v; acc[10] += w[9] * v; acc[9] += w[10] * v; acc[8] += w[11] * v; acc[7] += w[12] * v; acc[6] += w[13] * v; acc[5] += w[14] * v; acc[4] += w[15] * v; acc[3] += w[16] * v; acc[2] += w[17] * v; acc[1] += w[18] * v; acc[0] += w[19] * v; }
    asm volatile("" ::: "memory");
    { const unsigned u = lin0[20 * 512]; f32x2 v; v.x = bflo(u); v.y = bfhi(u); acc[20] += w[0] * v; acc[19] += w[1] * v; acc[18] += w[2] * v; acc[17] += w[3] * v; acc[16] += w[4] * v; acc[15] += w[5] * v; acc[14] += w[6] * v; acc[13] += w[7] * v; acc[12] += w[8] * v; acc[11] += w[9] * v; acc[10] += w[10] * v; acc[9] += w[11] * v; acc[8] += w[12] * v; acc[7] += w[13] * v; acc[6] += w[14] * v; acc[5] += w[15] * v; acc[4] += w[16] * v; acc[3] += w[17] * v; acc[2] += w[18] * v; acc[1] += w[19] * v; acc[0] += w[20] * v; }
    { const unsigned u = lin0[21 * 512]; f32x2 v; v.x = bflo(u); v.y = bfhi(u); acc[21] += w[0] * v; acc[20] += w[1] * v; acc[19] += w[2] * v; acc[18] += w[3] * v; acc[17] += w[4] * v; acc[16] += w[5] * v; acc[15] += w[6] * v; acc[14] += w[7] * v; acc[13] += w[8] * v; acc[12] += w[9] * v; acc[11] += w[10] * v; acc[10] += w[11] * v; acc[9] += w[12] * v; acc[8] += w[13] * v; acc[7] += w[14] * v; acc[6] += w[15] * v; acc[5] += w[16] * v; acc[4] += w[17] * v; acc[3] += w[18] * v; acc[2] += w[19] * v; acc[1] += w[20] * v; acc[0] += w[21] * v; }
    asm volatile("" ::: "memory");
    { const unsigned u = lin0[22 * 512]; f32x2 v; v.x = bflo(u); v.y = bfhi(u); acc[22] += w[0] * v; acc[21] += w[1] * v; acc[20] += w[2] * v; acc[19] += w[3] * v; acc[18] += w[4] * v; acc[17] += w[5] * v; acc[16] += w[6] * v; acc[15] += w[7] * v; acc[14] += w[8] * v; acc[13] += w[9] * v; acc[12] += w[10] * v; acc[11] += w[11] * v; acc[10] += w[12] * v; acc[9] += w[13] * v; acc[8] += w[14] * v; acc[7] += w[15] * v; acc[6] += w[16] * v; acc[5] += w[17] * v; acc[4] += w[18] * v; acc[3] += w[19] * v; acc[2] += w[20] * v; acc[1] += w[21] * v; acc[0] += w[22] * v; }
    { const unsigned u = lin0[23 * 512]; f32x2 v; v.x = bflo(u); v.y = bfhi(u); acc[23] += w[0] * v; acc[22] += w[1] * v; acc[21] += w[2] * v; acc[20] += w[3] * v; acc[19] += w[4] * v; acc[18] += w[5] * v; acc[17] += w[6] * v; acc[16] += w[7] * v; acc[15] += w[8] * v; acc[14] += w[9] * v; acc[13] += w[10] * v; acc[12] += w[11] * v; acc[11] += w[12] * v; acc[10] += w[13] * v; acc[9] += w[14] * v; acc[8] += w[15] * v; acc[7] += w[16] * v; acc[6] += w[17] * v; acc[5] += w[18] * v; acc[4] += w[19] * v; acc[3] += w[20] * v; acc[2] += w[21] * v; acc[1] += w[22] * v; acc[0] += w[23] * v; }
    asm volatile("" ::: "memory");
    { const unsigned u = lin0[24 * 512]; f32x2 v; v.x = bflo(u); v.y = bfhi(u); acc[24] += w[0] * v; acc[23] += w[1] * v; acc[22] += w[2] * v; acc[21] += w[3] * v; acc[20] += w[4] * v; acc[19] += w[5] * v; acc[18] += w[6] * v; acc[17] += w[7] * v; acc[16] += w[8] * v; acc[15] += w[9] * v; acc[14] += w[10] * v; acc[13] += w[11] * v; acc[12] += w[12] * v; acc[11] += w[13] * v; acc[10] += w[14] * v; acc[9] += w[15] * v; acc[8] += w[16] * v; acc[7] += w[17] * v; acc[6] += w[18] * v; acc[5] += w[19] * v; acc[4] += w[20] * v; acc[3] += w[21] * v; acc[2] += w[22] * v; acc[1] += w[23] * v; acc[0] += w[24] * v; }
    { const unsigned u = lin0[25 * 512]; f32x2 v; v.x = bflo(u); v.y = bfhi(u); acc[25] += w[0] * v; acc[24] += w[1] * v; acc[23] += w[2] * v; acc[22] += w[3] * v; acc[21] += w[4] * v; acc[20] += w[5] * v; acc[19] += w[6] * v; acc[18] += w[7] * v; acc[17] += w[8] * v; acc[16] += w[9] * v; acc[15] += w[10] * v; acc[14] += w[11] * v; acc[13] += w[12] * v; acc[12] += w[13] * v; acc[11] += w[14] * v; acc[10] += w[15] * v; acc[9] += w[16] * v; acc[8] += w[17] * v; acc[7] += w[18] * v; acc[6] += w[19] * v; acc[5] += w[20] * v; acc[4] += w[21] * v; acc[3] += w[22] * v; acc[2] += w[23] * v; acc[1] += w[24] * v; acc[0] += w[25] * v; }
    asm volatile("" ::: "memory");
    { const unsigned u = lin0[26 * 512]; f32x2 v; v.x = bflo(u); v.y = bfhi(u); acc[26] += w[0] * v; acc[25] += w[1] * v; acc[24] += w[2] * v; acc[23] += w[3] * v; acc[22] += w[4] * v; acc[21] += w[5] * v; acc[20] += w[6] * v; acc[19] += w[7] * v; acc[18] += w[8] * v; acc[17] += w[9] * v; acc[16] += w[10] * v; acc[15] += w[11] * v; acc[14] += w[12] * v; acc[13] += w[13] * v; acc[12] += w[14] * v; acc[11] += w[15] * v; acc[10] += w[16] * v; acc[9] += w[17] * v; acc[8] += w[18] * v; acc[7] += w[19] * v; acc[6] += w[20] * v; acc[5] += w[21] * v; acc[4] += w[22] * v; acc[3] += w[23] * v; acc[2] += w[24] * v; acc[1] += w[25] * v; acc[0] += w[26] * v; }
    { const unsigned u = lin0[27 * 512]; f32x2 v; v.x = bflo(u); v.y = bfhi(u); acc[27] += w[0] * v; acc[26] += w[1] * v; acc[25] += w[2] * v; acc[24] += w[3] * v; acc[23] += w[4] * v; acc[22] += w[5] * v; acc[21] += w[6] * v; acc[20] += w[7] * v; acc[19] += w[8] * v; acc[18] += w[9] * v; acc[17] += w[10] * v; acc[16] += w[11] * v; acc[15] += w[12] * v; acc[14] += w[13] * v; acc[13] += w[14] * v; acc[12] += w[15] * v; acc[11] += w[16] * v; acc[10] += w[17] * v; acc[9] += w[18] * v; acc[8] += w[19] * v; acc[7] += w[20] * v; acc[6] += w[21] * v; acc[5] += w[22] * v; acc[4] += w[23] * v; acc[3] += w[24] * v; acc[2] += w[25] * v; acc[1] += w[26] * v; acc[0] += w[27] * v; }
    asm volatile("" ::: "memory");
    { const unsigned u = lin0[28 * 512]; f32x2 v; v.x = bflo(u); v.y = bfhi(u); acc[28] += w[0] * v; acc[27] += w[1] * v; acc[26] += w[2] * v; acc[25] += w[3] * v; acc[24] += w[4] * v; acc[23] += w[5] * v; acc[22] += w[6] * v; acc[21] += w[7] * v; acc[20] += w[8] * v; acc[19] += w[9] * v; acc[18] += w[10] * v; acc[17] += w[11] * v; acc[16] += w[12] * v; acc[15] += w[13] * v; acc[14] += w[14] * v; acc[13] += w[15] * v; acc[12] += w[16] * v; acc[11] += w[17] * v; acc[10] += w[18] * v; acc[9] += w[19] * v; acc[8] += w[20] * v; acc[7] += w[21] * v; acc[6] += w[22] * v; acc[5] += w[23] * v; acc[4] += w[24] * v; acc[3] += w[25] * v; acc[2] += w[26] * v; acc[1] += w[27] * v; acc[0] += w[28] * v; }
    { const unsigned u = lin0[29 * 512]; f32x2 v; v.x = bflo(u); v.y = bfhi(u); acc[29] += w[0] * v; acc[28] += w[1] * v; acc[27] += w[2] * v; acc[26] += w[3] * v; acc[25] += w[4] * v; acc[24] += w[5] * v; acc[23] += w[6] * v; acc[22] += w[7] * v; acc[21] += w[8] * v; acc[20] += w[9] * v; acc[19] += w[10] * v; acc[18] += w[11] * v; acc[17] += w[12] * v; acc[16] += w[13] * v; acc[15] += w[14] * v; acc[14] += w[15] * v; acc[13] += w[16] * v; acc[12] += w[17] * v; acc[11] += w[18] * v; acc[10] += w[19] * v; acc[9] += w[20] * v; acc[8] += w[21] * v; acc[7] += w[22] * v; acc[6] += w[23] * v; acc[5] += w[24] * v; acc[4] += w[25] * v; acc[3] += w[26] * v; acc[2] += w[27] * v; acc[1] += w[28] * v; acc[0] += w[29] * v; }
    asm volatile("" ::: "memory");
    { const unsigned u = lin0[30 * 512]; f32x2 v; v.x = bflo(u); v.y = bfhi(u); acc[30] += w[0] * v; acc[29] += w[1] * v; acc[28] += w[2] * v; acc[27] += w[3] * v; acc[26] += w[4] * v; acc[25] += w[5] * v; acc[24] += w[6] * v; acc[23] += w[7] * v; acc[22] += w[8] * v; acc[21] += w[9] * v; acc[20] += w[10] * v; acc[19] += w[11] * v; acc[18] += w[12] * v; acc[17] += w[13] * v; acc[16] += w[14] * v; acc[15] += w[15] * v; acc[14] += w[16] * v; acc[13] += w[17] * v; acc[12] += w[18] * v; acc[11] += w[19] * v; acc[10] += w[20] * v; acc[9] += w[21] * v; acc[8] += w[22] * v; acc[7] += w[23] * v; acc[6] += w[24] * v; acc[5] += w[25] * v; acc[4] += w[26] * v; acc[3] += w[27] * v; acc[2] += w[28] * v; acc[1] += w[29] * v; acc[0] += w[30] * v; }
    { const unsigned u = lin1[0 * 512]; f32x2 v; v.x = bflo(u); v.y = bfhi(u); acc[31] += w[0] * v; acc[30] += w[1] * v; acc[29] += w[2] * v; acc[28] += w[3] * v; acc[27] += w[4] * v; acc[26] += w[5] * v; acc[25] += w[6] * v; acc[24] += w[7] * v; acc[23] += w[8] * v; acc[22] += w[9] * v; acc[21] += w[10] * v; acc[20] += w[11] * v; acc[19] += w[12] * v; acc[18] += w[13] * v; acc[17] += w[14] * v; acc[16] += w[15] * v; acc[15] += w[16] * v; acc[14] += w[17] * v; acc[13] += w[18] * v; acc[12] += w[19] * v; acc[11] += w[20] * v; acc[10] += w[21] * v; acc[9] += w[22] * v; acc[8] += w[23] * v; acc[7] += w[24] * v; acc[6] += w[25] * v; acc[5] += w[26] * v; acc[4] += w[27] * v; acc[3] += w[28] * v; acc[2] += w[29] * v; acc[1] += w[30] * v; }
    asm volatile("" ::: "memory");
    { const unsigned u = lin1[1 * 512]; f32x2 v; v.x = bflo(u); v.y = bfhi(u); acc[31] += w[1] * v; acc[30] += w[2] * v; acc[29] += w[3] * v; acc[28] += w[4] * v; acc[27] += w[5] * v; acc[26] += w[6] * v; acc[25] += w[7] * v; acc[24] += w[8] * v; acc[23] += w[9] * v; acc[22] += w[10] * v; acc[21] += w[11] * v; acc[20] += w[12] * v; acc[19] += w[13] * v; acc[18] += w[14] * v; acc[17] += w[15] * v; acc[16] += w[16] * v; acc[15] += w[17] * v; acc[14] += w[18] * v; acc[13] += w[19] * v; acc[12] += w[20] * v; acc[11] += w[21] * v; acc[10] += w[22] * v; acc[9] += w[23] * v; acc[8] += w[24] * v; acc[7] += w[25] * v; acc[6] += w[26] * v; acc[5] += w[27] * v; acc[4] += w[28] * v; acc[3] += w[29] * v; acc[2] += w[30] * v; }
    { const unsigned u = lin1[2 * 512]; f32x2 v; v.x = bflo(u); v.y = bfhi(u); acc[31] += w[2] * v; acc[30] += w[3] * v; acc[29] += w[4] * v; acc[28] += w[5] * v; acc[27] += w[6] * v; acc[26] += w[7] * v; acc[25] += w[8] * v; acc[24] += w[9] * v; acc[23] += w[10] * v; acc[22] += w[11] * v; acc[21] += w[12] * v; acc[20] += w[13] * v; acc[19] += w[14] * v; acc[18] += w[15] * v; acc[17] += w[16] * v; acc[16] += w[17] * v; acc[15] += w[18] * v; acc[14] += w[19] * v; acc[13] += w[20] * v; acc[12] += w[21] * v; acc[11] += w[22] * v; acc[10] += w[23] * v; acc[9] += w[24] * v; acc[8] += w[25] * v; acc[7] += w[26] * v; acc[6] += w[27] * v; acc[5] += w[28] * v; acc[4] += w[29] * v; acc[3] += w[30] * v; }
    asm volatile("" ::: "memory");
    { const unsigned u = lin1[3 * 512]; f32x2 v; v.x = bflo(u); v.y = bfhi(u); acc[31] += w[3] * v; acc[30] += w[4] * v; acc[29] += w[5] * v; acc[28] += w[6] * v; acc[27] += w[7] * v; acc[26] += w[8] * v; acc[25] += w[9] * v; acc[24] += w[10] * v; acc[23] += w[11] * v; acc[22] += w[12] * v; acc[21] += w[13] * v; acc[20] += w[14] * v; acc[19] += w[15] * v; acc[18] += w[16] * v; acc[17] += w[17] * v; acc[16] += w[18] * v; acc[15] += w[19] * v; acc[14] += w[20] * v; acc[13] += w[21] * v; acc[12] += w[22] * v; acc[11] += w[23] * v; acc[10] += w[24] * v; acc[9] += w[25] * v; acc[8] += w[26] * v; acc[7] += w[27] * v; acc[6] += w[28] * v; acc[5] += w[29] * v; acc[4] += w[30] * v; }
    { const unsigned u = lin1[4 * 512]; f32x2 v; v.x = bflo(u); v.y = bfhi(u); acc[31] += w[4] * v; acc[30] += w[5] * v; acc[29] += w[6] * v; acc[28] += w[7] * v; acc[27] += w[8] * v; acc[26] += w[9] * v; acc[25] += w[10] * v; acc[24] += w[11] * v; acc[23] += w[12] * v; acc[22] += w[13] * v; acc[21] += w[14] * v; acc[20] += w[15] * v; acc[19] += w[16] * v; acc[18] += w[17] * v; acc[17] += w[18] * v; acc[16] += w[19] * v; acc[15] += w[20] * v; acc[14] += w[21] * v; acc[13] += w[22] * v; acc[12] += w[23] * v; acc[11] += w[24] * v; acc[10] += w[25] * v; acc[9] += w[26] * v; acc[8] += w[27] * v; acc[7] += w[28] * v; acc[6] += w[29] * v; acc[5] += w[30] * v; }
    asm volatile("" ::: "memory");
    { const unsigned u = lin1[5 * 512]; f32x2 v; v.x = bflo(u); v.y = bfhi(u); acc[31] += w[5] * v; acc[30] += w[6] * v; acc[29] += w[7] * v; acc[28] += w[8] * v; acc[27] += w[9] * v; acc[26] += w[10] * v; acc[25] += w[11] * v; acc[24] += w[12] * v; acc[23] += w[13] * v; acc[22] += w[14] * v; acc[21] += w[15] * v; acc[20] += w[16] * v; acc[19] += w[17] * v; acc[18] += w[18] * v; acc[17] += w[19] * v; acc[16] += w[20] * v; acc[15] += w[21] * v; acc[14] += w[22] * v; acc[13] += w[23] * v; acc[12] += w[24] * v; acc[11] += w[25] * v; acc[10] += w[26] * v; acc[9] += w[27] * v; acc[8] += w[28] * v; acc[7] += w[29] * v; acc[6] += w[30] * v; }
    { const unsigned u = lin1[6 * 512]; f32x2 v; v.x = bflo(u); v.y = bfhi(u); acc[31] += w[6] * v; acc[30] += w[7] * v; acc[29] += w[8] * v; acc[28] += w[9] * v; acc[27] += w[10] * v; acc[26] += w[11] * v; acc[25] += w[12] * v; acc[24] += w[13] * v; acc[23] += w[14] * v; acc[22] += w[15] * v; acc[21] += w[16] * v; acc[20] += w[17] * v; acc[19] += w[18] * v; acc[18] += w[19] * v; acc[17] += w[20] * v; acc[16] += w[21] * v; acc[15] += w[22] * v; acc[14] += w[23] * v; acc[13] += w[24] * v; acc[12] += w[25] * v; acc[11] += w[26] * v; acc[10] += w[27] * v; acc[9] += w[28] * v; acc[8] += w[29] * v; acc[7] += w[30] * v; }
    asm volatile("" ::: "memory");
    { const unsigned u = lin1[7 * 512]; f32x2 v; v.x = bflo(u); v.y = bfhi(u); acc[31] += w[7] * v; acc[30] += w[8] * v; acc[29] += w[9] * v; acc[28] += w[10] * v; acc[27] += w[11] * v; acc[26] += w[12] * v; acc[25] += w[13] * v; acc[24] += w[14] * v; acc[23] += w[15] * v; acc[22] += w[16] * v; acc[21] += w[17] * v; acc[20] += w[18] * v; acc[19] += w[19] * v; acc[18] += w[20] * v; acc[17] += w[21] * v; acc[16] += w[22] * v; acc[15] += w[23] * v; acc[14] += w[24] * v; acc[13] += w[25] * v; acc[12] += w[26] * v; acc[11] += w[27] * v; acc[10] += w[28] * v; acc[9] += w[29] * v; acc[8] += w[30] * v; }
    { const unsigned u = lin1[8 * 512]; f32x2 v; v.x = bflo(u); v.y = bfhi(u); acc[31] += w[8] * v; acc[30] += w[9] * v; acc[29] += w[10] * v; acc[28] += w[11] * v; acc[27] += w[12] * v; acc[26] += w[13] * v; acc[25] += w[14] * v; acc[24] += w[15] * v; acc[23] += w[16] * v; acc[22] += w[17] * v; acc[21] += w[18] * v; acc[20] += w[19] * v; acc[19] += w[20] * v; acc[18] += w[21] * v; acc[17] += w[22] * v; acc[16] += w[23] * v; acc[15] += w[24] * v; acc[14] += w[25] * v; acc[13] += w[26] * v; acc[12] += w[27] * v; acc[11] += w[28] * v; acc[10] += w[29] * v; acc[9] += w[30] * v; }
    asm volatile("" ::: "memory");
    { const unsigned u = lin1[9 * 512]; f32x2 v; v.x = bflo(u); v.y = bfhi(u); acc[31] += w[9] * v; acc[30] += w[10] * v; acc[29] += w[11] * v; acc[28] += w[12] * v; acc[27] += w[13] * v; acc[26] += w[14] * v; acc[25] += w[15] * v; acc[24] += w[16] * v; acc[23] += w[17] * v; acc[22] += w[18] * v; acc[21] += w[19] * v; acc[20] += w[20] * v; acc[19] += w[21] * v; acc[18] += w[22] * v; acc[17] += w[23] * v; acc[16] += w[24] * v; acc[15] += w[25] * v; acc[14] += w[26] * v; acc[13] += w[27] * v; acc[12] += w[28] * v; acc[11] += w[29] * v; acc[10] += w[30] * v; }
    { const unsigned u = lin1[10 * 512]; f32x2 v; v.x = bflo(u); v.y = bfhi(u); acc[31] += w[10] * v; acc[30] += w[11] * v; acc[29] += w[12] * v; acc[28] += w[13] * v; acc[27] += w[14] * v; acc[26] += w[15] * v; acc[25] += w[16] * v; acc[24] += w[17] * v; acc[23] += w[18] * v; acc[22] += w[19] * v; acc[21] += w[20] * v; acc[20] += w[21] * v; acc[19] += w[22] * v; acc[18] += w[23] * v; acc[17] += w[24] * v; acc[16] += w[25] * v; acc[15] += w[26] * v; acc[14] += w[27] * v; acc[13] += w[28] * v; acc[12] += w[29] * v; acc[11] += w[30] * v; }
    asm volatile("" ::: "memory");
    { const unsigned u = lin1[11 * 512]; f32x2 v; v.x = bflo(u); v.y = bfhi(u); acc[31] += w[11] * v; acc[30] += w[12] * v; acc[29] += w[13] * v; acc[28] += w[14] * v; acc[27] += w[15] * v; acc[26] += w[16] * v; acc[25] += w[17] * v; acc[24] += w[18] * v; acc[23] += w[19] * v; acc[22] += w[20] * v; acc[21] += w[21] * v; acc[20] += w[22] * v; acc[19] += w[23] * v; acc[18] += w[24] * v; acc[17] += w[25] * v; acc[16] += w[26] * v; acc[15] += w[27] * v; acc[14] += w[28] * v; acc[13] += w[29] * v; acc[12] += w[30] * v; }
    { const unsigned u = lin1[12 * 512]; f32x2 v; v.x = bflo(u); v.y = bfhi(u); acc[31] += w[12] * v; acc[30] += w[13] * v; acc[29] += w[14] * v; acc[28] += w[15] * v; acc[27] += w[16] * v; acc[26] += w[17] * v; acc[25] += w[18] * v; acc[24] += w[19] * v; acc[23] += w[20] * v; acc[22] += w[21] * v; acc[21] += w[22] * v; acc[20] += w[23] * v; acc[19] += w[24] * v; acc[18] += w[25] * v; acc[17] += w[26] * v; acc[16] += w[27] * v; acc[15] += w[28] * v; acc[14] += w[29] * v; acc[13] += w[30] * v; }
    asm volatile("" ::: "memory");
    { const unsigned u = lin1[13 * 512]; f32x2 v; v.x = bflo(u); v.y = bfhi(u); acc[31] += w[13] * v; acc[30] += w[14] * v; acc[29] += w[15] * v; acc[28] += w[16] * v; acc[27] += w[17] * v; acc[26] += w[18] * v; acc[25] += w[19] * v; acc[24] += w[20] * v; acc[23] += w[21] * v; acc[22] += w[22] * v; acc[21] += w[23] * v; acc[20] += w[24] * v; acc[19] += w[25] * v; acc[18] += w[26] * v; acc[17] += w[27] * v; acc[16] += w[28] * v; acc[15] += w[29] * v; acc[14] += w[30] * v; }
    { const unsigned u = lin1[14 * 512]; f32x2 v; v.x = bflo(u); v.y = bfhi(u); acc[31] += w[14] * v; acc[30] += w[15] * v; acc[29] += w[16] * v; acc[28] += w[17] * v; acc[27] += w[18] * v; acc[26] += w[19] * v; acc[25] += w[20] * v; acc[24] += w[21] * v; acc[23] += w[22] * v; acc[22] += w[23] * v; acc[21] += w[24] * v; acc[20] += w[25] * v; acc[19] += w[26] * v; acc[18] += w[27] * v; acc[17] += w[28] * v; acc[16] += w[29] * v; acc[15] += w[30] * v; }
    asm volatile("" ::: "memory");
    { const unsigned u = lin1[15 * 512]; f32x2 v; v.x = bflo(u); v.y = bfhi(u); acc[31] += w[15] * v; acc[30] += w[16] * v; acc[29] += w[17] * v; acc[28] += w[18] * v; acc[27] += w[19] * v; acc[26] += w[20] * v; acc[25] += w[21] * v; acc[24] += w[22] * v; acc[23] += w[23] * v; acc[22] += w[24] * v; acc[21] += w[25] * v; acc[20] += w[26] * v; acc[19] += w[27] * v; acc[18] += w[28] * v; acc[17] += w[29] * v; acc[16] += w[30] * v; }
    { const unsigned u = lin1[16 * 512]; f32x2 v; v.x = bflo(u); v.y = bfhi(u); acc[31] += w[16] * v; acc[30] += w[17] * v; acc[29] += w[18] * v; acc[28] += w[19] * v; acc[27] += w[20] * v; acc[26] += w[21] * v; acc[25] += w[22] * v; acc[24] += w[23] * v; acc[23] += w[24] * v; acc[22] += w[25] * v; acc[21] += w[26] * v; acc[20] += w[27] * v; acc[19] += w[28] * v; acc[18] += w[29] * v; acc[17] += w[30] * v; }
    asm volatile("" ::: "memory");
    { const unsigned u = lin1[17 * 512]; f32x2 v; v.x = bflo(u); v.y = bfhi(u); acc[31] += w[17] * v; acc[30] += w[18] * v; acc[29] += w[19] * v; acc[28] += w[20] * v; acc[27] += w[21] * v; acc[26] += w[22] * v; acc[25] += w[23] * v; acc[24] += w[24] * v; acc[23] += w[25] * v; acc[22] += w[26] * v; acc[21] += w[27] * v; acc[20] += w[28] * v; acc[19] += w[29] * v; acc[18] += w[30] * v; }
    { const unsigned u = lin1[18 * 512]; f32x2 v; v.x = bflo(u); v.y = bfhi(u); acc[31] += w[18] * v; acc[30] += w[19] * v; acc[29] += w[20] * v; acc[28] += w[21] * v; acc[27] += w[22] * v; acc[26] += w[23] * v; acc[25] += w[24] * v; acc[24] += w[25] * v; acc[23] += w[26] * v; acc[22] += w[27] * v; acc[21] += w[28] * v; acc[20] += w[29] * v; acc[19] += w[30] * v; }
    asm volatile("" ::: "memory");
    { const unsigned u = lin1[19 * 512]; f32x2 v; v.x = bflo(u); v.y = bfhi(u); acc[31] += w[19] * v; acc[30] += w[20] * v; acc[29] += w[21] * v; acc[28] += w[22] * v; acc[27] += w[23] * v; acc[26] += w[24] * v; acc[25] += w[25] * v; acc[24] += w[26] * v; acc[23] += w[27] * v; acc[22] += w[28] * v; acc[21] += w[29] * v; acc[20] += w[30] * v; }
    { const unsigned u = lin1[20 * 512]; f32x2 v; v.x = bflo(u); v.y = bfhi(u); acc[31] += w[20] * v; acc[30] += w[21] * v; acc[29] += w[22] * v; acc[28] += w[23] * v; acc[27] += w[24] * v; acc[26] += w[25] * v; acc[25] += w[26] * v; acc[24] += w[27] * v; acc[23] += w[28] * v; acc[22] += w[29] * v; acc[21] += w[30] * v; }
    asm volatile("" ::: "memory");
    { const unsigned u = lin1[21 * 512]; f32x2 v; v.x = bflo(u); v.y = bfhi(u); acc[31] += w[21] * v; acc[30] += w[22] * v; acc[29] += w[23] * v; acc[28] += w[24] * v; acc[27] += w[25] * v; acc[26] += w[26] * v; acc[25] += w[27] * v; acc[24] += w[28] * v; acc[23] += w[29] * v; acc[22] += w[30] * v; }
    { const unsigned u = lin1[22 * 512]; f32x2 v; v.x = bflo(u); v.y = bfhi(u); acc[31] += w[22] * v; acc[30] += w[23] * v; acc[29] += w[24] * v; acc[28] += w[25] * v; acc[27] += w[26] * v; acc[26] += w[27] * v; acc[25] += w[28] * v; acc[24] += w[29] * v; acc[23] += w[30] * v; }
    asm volatile("" ::: "memory");
    { const unsigned u = lin1[23 * 512]; f32x2 v; v.x = bflo(u); v.y = bfhi(u); acc[31] += w[23] * v; acc[30] += w[24] * v; acc[29] += w[25] * v; acc[28] += w[26] * v; acc[27] += w[27] * v; acc[26] += w[28] * v; acc[25] += w[29] * v; acc[24] += w[30] * v; }
    { const unsigned u = lin1[24 * 512]; f32x2 v; v.x = bflo(u); v.y = bfhi(u); acc[31] += w[24] * v; acc[30] += w[25] * v; acc[29] += w[26] * v; acc[28] += w[27] * v; acc[27] += w[28] * v; acc[26] += w[29] * v; acc[25] += w[30] * v; }
    asm volatile("" ::: "memory");
    { const unsigned u = lin1[25 * 512]; f32x2 v; v.x = bflo(u); v.y = bfhi(u); acc[31] += w[25] * v; acc[30] += w[26] * v; acc[29] += w[27] * v; acc[28] += w[28] * v; acc[27] += w[29] * v; acc[26] += w[30] * v; }
    { const unsigned u = lin1[26 * 512]; f32x2 v; v.x = bflo(u); v.y = bfhi(u); acc[31] += w[26] * v; acc[30] += w[27] * v; acc[29] += w[28] * v; acc[28] += w[29] * v; acc[27] += w[30] * v; }
    asm volatile("" ::: "memory");
    { const unsigned u = lin1[27 * 512]; f32x2 v; v.x = bflo(u); v.y = bfhi(u); acc[31] += w[27] * v; acc[30] += w[28] * v; acc[29] += w[29] * v; acc[28] += w[30] * v; }
    { const unsigned u = lin1[28 * 512]; f32x2 v; v.x = bflo(u); v.y = bfhi(u); acc[31] += w[28] * v; acc[30] += w[29] * v; acc[29] += w[30] * v; }
    asm volatile("" ::: "memory");
    { const unsigned u = lin1[29 * 512]; f32x2 v; v.x = bflo(u); v.y = bfhi(u); acc[31] += w[29] * v; acc[30] += w[30] * v; }
    { const unsigned u = lin1[30 * 512]; f32x2 v; v.x = bflo(u); v.y = bfhi(u); acc[31] += w[30] * v; }
    asm volatile("" ::: "memory");
    __syncthreads();
#pragma unroll
    for (int t = 0; t < 32; ++t) part[t * 520 + tid] = acc[t].x + acc[t].y;
    __syncthreads();
    { const int tk = tid >> 4, sub = tid & 15; float s = 0.f;
#pragma unroll 8
        for (int i = 0; i < 32; ++i) s += part[tk * 520 + sub + 16 * i];
        s += __shfl_xor(s, 1); s += __shfl_xor(s, 2); s += __shfl_xor(s, 4); s += __shfl_xor(s, 8);
        if (sub == 0) stat[tk] = s * (1.f / 1024.f); }
    __syncthreads();
#pragma unroll
    for (int t = 0; t < 32; ++t) { const float m = stat[t]; acc[t].x -= m; acc[t].y -= m; }
    __syncthreads();
#pragma unroll
    for (int t = 0; t < 32; ++t) part[t * 520 + tid] = acc[t].x * acc[t].x + acc[t].y * acc[t].y;
    __syncthreads();
    { const int tk = tid >> 4, sub = tid & 15; float s = 0.f;
#pragma unroll 8
        for (int i = 0; i < 32; ++i) s += part[tk * 520 + sub + 16 * i];
        s += __shfl_xor(s, 1); s += __shfl_xor(s, 2); s += __shfl_xor(s, 4); s += __shfl_xor(s, 8);
        if (sub == 0) stat[tk] = 1.f / sqrtf(s * (1.f / 1024.f) + LN_EPS); }
    __syncthreads();
    const f32x2 lg = *(const f32x2*)(a.in[I_CLNG] + c), lb = *(const f32x2*)(a.in[I_CLNB] + c);
#pragma unroll
    for (int t = 0; t < 32; ++t) { const float rs = stat[t]; float y0 = acc[t].x * rs * lg.x + lb.x, y1 = acc[t].y * rs * lg.y + lb.y; y0 *= sigm(y0); y1 *= sigm(y1);
        *(unsigned*)(CAT + (size_t)(r0 + t) * 2048 + c) = pk(y0, y1); }
    __syncthreads();
    (void)lane;
}
#ifdef NO_S5
#define S5CALL(x)
#else
#define S5CALL(x) x
#endif
#ifdef NO_CONV
#define CONVCALL(x)
#else
#define CONVCALL(x) x
#endif
__device__ __forceinline__ void p_s5_conv(const Args& a, unsigned char* lds, int bid, int G) {
    if (G >= 64) {
        if (bid < 32) { S5CALL(s5_block(a, lds, true, bid)); return; }
        for (int tk = bid - 32; tk < 512; tk += G - 32) { S5CALL(s5_block(a, lds, false, tk)); }
    } else {
        for (int tk = bid; tk < 544; tk += G) { if (tk < 32) { S5CALL(s5_block(a, lds, true, tk)); } else { S5CALL(s5_block(a, lds, false, tk - 32)); } }
    }
}

__device__ __forceinline__ bf16x8 pack8(const f32x16& p, int o) {
    return __builtin_bit_cast(bf16x8, (u32x4){pk(p[o], p[o + 1]), pk(p[o + 2], p[o + 3]), pk(p[o + 4], p[o + 5]), pk(p[o + 6], p[o + 7])});
}
__device__ __forceinline__ void attn_unit(const Args& a, unsigned char* lds, bool sample, int b, int h, int qb, float lam, float out_scale) {
    const int tid = threadIdx.x, lane = tid & 63, wave = tid >> 6, r32 = lane & 31, hi = lane >> 5, mp = wave >> 2, wq = wave & 3;
    const int nk = sample ? 2560 : 256, nt = nk / 64;
    const bf16* K0 = sample ? (const bf16*)(a.ws + WS_KS) + (size_t)(b * 32 + h) * 2560 * 64 : (const bf16*)(a.ws + WS_KP) + (size_t)(b * 32 + h) * 256 * 64;
    const bf16* K1 = K0 + (size_t)16 * nk * 64;
    const bf16* VT = sample ? (const bf16*)(a.ws + WS_VTS) + (size_t)(b * 16 + h) * 128 * 2560 : (const bf16*)(a.ws + WS_VTP) + (size_t)(b * 16 + h) * 128 * 256;
    const int qrow0 = (sample ? TP + b * 2048 : b * 256) + qb * 128 + wq * 32;
    const bf16* QB = (const bf16*)(a.ws + WS_QB);
    bf16x8 qf[4];
#pragma unroll
    for (int d0 = 0; d0 < 4; ++d0) qf[d0] = *(const bf16x8*)(QB + (size_t)(qrow0 + r32) * 2048 + mp * 1024 + h * 64 + d0 * 16 + hi * 8);
    f32x16 O[4];
#pragma unroll
    for (int d = 0; d < 4; ++d)
#pragma unroll
        for (int r = 0; r < 16; ++r) O[d][r] = 0.f;
    float mrun = -1e30f, lsum = 0.f;
    float* xch = (float*)(lds + 73728);
    const int skey = tid >> 3, sc = tid & 7;
    const unsigned char* kb = lds + mp * 9216 + r32 * 144 + hi * 16;
    const unsigned char* vb = lds + 18432 + r32 * 144 + hi * 16;
    unsigned char* skp = lds + skey * 144 + sc * 16;
    unsigned char* svp = lds + 18432 + skey * 144 + (16 * (sc >> 1) + 4 * (sc & 1)) * 2;
    u32x4 sk0, sk1, sv0, sv1;
#define ATT_LOAD(kt) do { sk0 = *(const u32x4*)(K0 + (size_t)((kt) * 64 + skey) * 64 + sc * 8); sk1 = *(const u32x4*)(K1 + (size_t)((kt) * 64 + skey) * 64 + sc * 8); \
        sv0 = *(const u32x4*)(VT + (size_t)skey * nk + (kt) * 64 + sc * 8); sv1 = *(const u32x4*)(VT + (size_t)(64 + skey) * nk + (kt) * 64 + sc * 8); } while (0)
#define ATT_STORE(BO) do { *(u32x4*)(skp + (BO)) = sk0; *(u32x4*)(skp + (BO) + 9216) = sk1; \
        *(u32x2*)(svp + (BO)) = (u32x2){sv0.x, sv0.y}; *(u32x2*)(svp + (BO) + 16) = (u32x2){sv0.z, sv0.w}; \
        *(u32x2*)(svp + (BO) + 9216) = (u32x2){sv1.x, sv1.y}; *(u32x2*)(svp + (BO) + 9232) = (u32x2){sv1.z, sv1.w}; } while (0)
    ATT_LOAD(0); VM_DRAIN(); ATT_STORE(0); ATT_LOAD(1);
    __syncthreads();
    for (int kt = 0; kt < nt; kt += 2) {
        { VM_DRAIN(); ATT_STORE(36864); if (kt + 2 < nt) ATT_LOAD(kt + 2); }
        {
        f32x16 p0, p1;
#pragma unroll
        for (int r = 0; r < 16; ++r) { p0[r] = 0.f; p1[r] = 0.f; }
#pragma unroll
        for (int d0 = 0; d0 < 4; ++d0) { const bf16x8 k0 = *(const bf16x8*)(kb + 0 + d0 * 32), k1 = *(const bf16x8*)(kb + 4608 + d0 * 32);
            p0 = __builtin_amdgcn_mfma_f32_32x32x16_bf16(k0, qf[d0], p0, 0, 0, 0); p1 = __builtin_amdgcn_mfma_f32_32x32x16_bf16(k1, qf[d0], p1, 0, 0, 0); }
        asm volatile("s_nop 15\n\ts_nop 15" : "+v"(p0), "+v"(p1));
        float mx = fmaxf(p0[0], p1[0]);
#pragma unroll
        for (int r = 1; r < 16; ++r) mx = fmaxf(mx, fmaxf(p0[r], p1[r]));
        mx = fmaxf(mx, __shfl_xor(mx, 32));
        const float mnew = fmaxf(mrun, mx), f = __builtin_amdgcn_exp2f(mrun - mnew); mrun = mnew;
        float s = 0.f;
#pragma unroll
        for (int r = 0; r < 16; ++r) { p0[r] = __builtin_amdgcn_exp2f(p0[r] - mnew); p1[r] = __builtin_amdgcn_exp2f(p1[r] - mnew); s += p0[r] + p1[r]; }
        lsum = lsum * f + s;
        if (__any(f != 1.0f)) {
#pragma unroll
            for (int d = 0; d < 4; ++d)
#pragma unroll
                for (int r = 0; r < 16; ++r) O[d][r] *= f; }
        bf16x8 pa[4]; pa[0] = pack8(p0, 0); pa[1] = pack8(p0, 8); pa[2] = pack8(p1, 0); pa[3] = pack8(p1, 8);
#pragma unroll
        for (int d = 0; d < 4; ++d)
#pragma unroll
            for (int s2 = 0; s2 < 4; ++s2) { const bf16x8 va = *(const bf16x8*)(vb + 0 + d * 4608 + s2 * 32);
                O[d] = __builtin_amdgcn_mfma_f32_32x32x16_bf16(va, pa[s2], O[d], 0, 0, 0); }
        }
        __syncthreads();
        if (kt + 2 < nt) { VM_DRAIN(); ATT_STORE(0); if (kt + 3 < nt) ATT_LOAD(kt + 3); }
        {
        f32x16 p0, p1;
#pragma unroll
        for (int r = 0; r < 16; ++r) { p0[r] = 0.f; p1[r] = 0.f; }
#pragma unroll
        for (int d0 = 0; d0 < 4; ++d0) { const bf16x8 k0 = *(const bf16x8*)(kb + 36864 + d0 * 32), k1 = *(const bf16x8*)(kb + 41472 + d0 * 32);
            p0 = __builtin_amdgcn_mfma_f32_32x32x16_bf16(k0, qf[d0], p0, 0, 0, 0); p1 = __builtin_amdgcn_mfma_f32_32x32x16_bf16(k1, qf[d0], p1, 0, 0, 0); }
        asm volatile("s_nop 15\n\ts_nop 15" : "+v"(p0), "+v"(p1));
        float mx = fmaxf(p0[0], p1[0]);
#pragma unroll
        for (int r = 1; r < 16; ++r) mx = fmaxf(mx, fmaxf(p0[r], p1[r]));
        mx = fmaxf(mx, __shfl_xor(mx, 32));
        const float mnew = fmaxf(mrun, mx), f = __builtin_amdgcn_exp2f(mrun - mnew); mrun = mnew;
        float s = 0.f;
#pragma unroll
        for (int r = 0; r < 16; ++r) { p0[r] = __builtin_amdgcn_exp2f(p0[r] - mnew); p1[r] = __builtin_amdgcn_exp2f(p1[r] - mnew); s += p0[r] + p1[r]; }
        lsum = lsum * f + s;
        if (__any(f != 1.0f)) {
#pragma unroll
            for (int d = 0; d < 4; ++d)
#pragma unroll
                for (int r = 0; r < 16; ++r) O[d][r] *= f; }
        bf16x8 pa[4]; pa[0] = pack8(p0, 0); pa[1] = pack8(p0, 8); pa[2] = pack8(p1, 0); pa[3] = pack8(p1, 8);
#pragma unroll
        for (int d = 0; d < 4; ++d)
#pragma unroll
            for (int s2 = 0; s2 < 4; ++s2) { const bf16x8 va = *(const bf16x8*)(vb + 36864 + d * 4608 + s2 * 32);
                O[d] = __builtin_amdgcn_mfma_f32_32x32x16_bf16(va, pa[s2], O[d], 0, 0, 0); }
        }
        __syncthreads();
    }
#undef ATT_LOAD
#undef ATT_STORE
    asm volatile("s_nop 15\n\ts_nop 15" : "+v"(O[0]), "+v"(O[1]), "+v"(O[2]), "+v"(O[3]));
    const float lt = lsum + __shfl_xor(lsum, 32);
    const float inv = (mp ? lam : 1.f) / lt;
    if (mp) {
#pragma unroll
        for (int d = 0; d < 4; ++d)
#pragma unroll
            for (int r = 0; r < 16; ++r) xch[(wq * 64 + d * 16 + r) * 64 + lane] = O[d][r] * inv;
    }
    __syncthreads();
    if (!mp) {
        float ss = 0.f;
#pragma unroll
        for (int d = 0; d < 4; ++d)
#pragma unroll
            for (int r = 0; r < 16; ++r) { const float o = O[d][r] * inv - xch[(wq * 64 + d * 16 + r) * 64 + lane]; O[d][r] = o; ss += o * o; }
        ss += __shfl_xor(ss, 32);
        const float rinv = 1.f / sqrtf(ss * (1.f / 128.f) + LN_EPS); (void)out_scale;
        unsigned char* stg = (unsigned char*)xch + wq * 16384;
#pragma unroll
        for (int d = 0; d < 4; ++d)
#pragma unroll
            for (int r = 0; r < 16; ++r) { const int dv = d * 32 + crow(r, hi); *(bf16*)(stg + r32 * 272 + dv * 2) = (bf16)pk(O[d][r] * rinv, 0.f); }
        LDS_FENCE();
        bf16* OA = (bf16*)(a.ws + WS_OA);
#pragma unroll
        for (int i = 0; i < 8; ++i) { const int id = lane + 64 * i, row = id >> 4, ch = id & 15; const u32x4 v = *(const u32x4*)(stg + row * 272 + ch * 16);
            *(u32x4*)(OA + (size_t)(qrow0 + row) * 2048 + h * 128 + ch * 8) = v; }
    }
}
__device__ __forceinline__ void p_attn(const Args& a, unsigned char* lds, int bid, int G) {
    const int lane = threadIdx.x & 63;
    const float lam_init = 0.8f - 0.6f * expf(-0.3f);
    const float d1 = wave_sum(a.in[I_LQ1][lane] * a.in[I_LK1][lane]), d2 = wave_sum(a.in[I_LQ2][lane] * a.in[I_LK2][lane]);
    const float lam = expf(d1) - expf(d2) + lam_init, osc = 1.f - lam_init;
    for (int tk = bid; tk < 1536; tk += G) {
        if (tk < 512) { int bh, qb; if (G == 256) { const int t2 = tk & 255; bh = (t2 & 7) * 4 + (t2 >> 6); qb = ((t2 >> 3) & 7) * 2 + (tk >> 8); } else { bh = tk >> 4; qb = tk & 15; }
            attn_unit(a, lds, true, bh >> 4, bh & 15, qb, lam, osc); }
        else { const int u = tk - 512; attn_unit(a, lds, false, u >> 5, (u >> 1) & 15, u & 1, lam, osc); }
    }
}
__device__ __forceinline__ void p_cache(const Args& a, unsigned char* lds, int bid, int G) {
    const int tid = threadIdx.x, lane = tid & 63, wave = tid >> 6;
    bf16* KS = (bf16*)(a.ws + WS_KS); bf16* VTS = (bf16*)(a.ws + WS_VTS);
    for (int e = bid * NTHR + tid; e < 262144; e += G * NTHR) {
        const int bmh = e >> 12, j = (e >> 3) & 511, d = (e & 7) * 8; const float* s = a.in[I_CK] + (size_t)e * 8;
        const f32x4 x0 = *(const f32x4*)s, x1 = *(const f32x4*)(s + 4); VM_DRAIN();
        *(u32x4*)(KS + ((size_t)bmh * 2560 + 2048 + j) * 64 + d) = (u32x4){pk(x0[0], x0[1]), pk(x0[2], x0[3]), pk(x1[0], x1[1]), pk(x1[2], x1[3])}; }
    float* scr = (float*)(lds + wave * 8704);
    for (int it = bid * NWAVE + wave; it < 1024; it += G * NWAVE) {
        const int bh = it >> 5, r = it & 31, kb = r >> 2, nb = r & 3;
        transpose_item(a.in[I_CV] + (size_t)bh * 512 * 128, 128, 64 * kb, 32 * nb, VTS + (size_t)bh * 128 * 2560, 2560, 32 * nb, 2048 + 64 * kb, scr, lane); }
    __syncthreads();
}

#define LAS __attribute__((address_space(3)))
#define XB_TMO      128
#define XB_XCNT(j)  (256  + 64 * (j))
#define XB_XSUB(j)  (1280 + 64 * (j))
#define XB_XGEN(j)  (2304 + 64 * (j))
#define XB_TOP      3328
#define XB_TOPGEN   3392
#define XCD_BAR_WORDS 3456
#define XB_SPIN_CAP (1u << 18)

__device__ __forceinline__ unsigned xb_ld(unsigned* p)              { return __hip_atomic_load(p, __ATOMIC_RELAXED, __HIP_MEMORY_SCOPE_AGENT); }
__device__ __forceinline__ unsigned xb_add(unsigned* p, unsigned v) { return __hip_atomic_fetch_add(p, v, __ATOMIC_RELAXED, __HIP_MEMORY_SCOPE_AGENT); }
__device__ __forceinline__ unsigned xb_xcc_id() { return (unsigned)__builtin_amdgcn_s_getreg((3 << 11) | 20) & 0xFu; }
#define XB_SPIN(cond, bar) do { unsigned _sp = 0; while (cond) { __builtin_amdgcn_s_sleep(1); \
    if ((++_sp & 255u) == 0u) { if (xb_ld(&(bar)[XB_TMO])) break; if (_sp > XB_SPIN_CAP) { atomicAdd(&(bar)[XB_TMO], 1u); break; } } } } while (0)

struct XcdBarrier {
    unsigned* bar; unsigned x;
    volatile LAS unsigned* st;
};

__device__ __forceinline__ XcdBarrier xcd_barrier_post(unsigned* bar, volatile LAS unsigned* st) {
    XcdBarrier b; b.bar = bar; b.x = xb_xcc_id(); b.st = st;
    if (threadIdx.x == 0) (void)xb_add(&bar[XB_XCNT(b.x)], 1u);
    return b;
}
__device__ __forceinline__ void xcd_barrier_complete(unsigned* bar, unsigned x, unsigned& nloc, unsigned& nx) {
    const unsigned G = gridDim.x * gridDim.y * gridDim.z;
    unsigned sum, cnt, mine, sp = 0u;
    for (;;) {
        sum = 0u; cnt = 0u; mine = 0u;
#pragma unroll
        for (unsigned j = 0; j < 16; ++j) { const unsigned c = xb_ld(&bar[XB_XCNT(j)]); sum += c; cnt += (c > 0u) ? 1u : 0u; mine = (j == x) ? c : mine; }
        if (sum == G) break;
        __builtin_amdgcn_s_sleep(1);
        if ((++sp & 255u) == 0u) { if (xb_ld(&bar[XB_TMO])) break; if (sp > XB_SPIN_CAP) { atomicAdd(&bar[XB_TMO], 1u); break; } }
    }
    nloc = mine > 0u ? mine : 1u; nx = cnt > 0u ? cnt : 1u;
}

__device__ __forceinline__ void xcd_barrier(const XcdBarrier& b) {
    asm volatile("s_waitcnt vmcnt(0)" ::: "memory");
    __syncthreads();
    if (threadIdx.x == 0) {
        unsigned* bar = b.bar;
        __builtin_amdgcn_s_waitcnt(0);
        unsigned nloc = b.st[0], nx = b.st[1];
        if (nloc == 0u) { xcd_barrier_complete(bar, b.x, nloc, nx); b.st[0] = nloc; b.st[1] = nx; }
        const unsigned old = xb_add(&bar[XB_XSUB(b.x)], 1u);
        const unsigned gen = old / nloc;
        if (old + 1u == (gen + 1u) * nloc) {
            __builtin_amdgcn_fence(__ATOMIC_RELEASE, "agent");
            asm volatile("s_waitcnt vmcnt(0)" ::: "memory");
            const unsigned og = xb_add(&bar[XB_TOP], 1u);
            const unsigned tg = og / nx;
            if (og + 1u == (tg + 1u) * nx) xb_add(&bar[XB_TOPGEN], 1u);
            else XB_SPIN(xb_ld(&bar[XB_TOPGEN]) == tg, bar);
            __builtin_amdgcn_fence(__ATOMIC_ACQUIRE, "agent");
            xb_add(&bar[XB_XGEN(b.x)], 1u);
            asm volatile("s_waitcnt vmcnt(0)" ::: "memory");
        } else {
            XB_SPIN(xb_ld(&bar[XB_XGEN(b.x)]) == gen, bar);
            __builtin_amdgcn_fence(__ATOMIC_ACQUIRE, "agent");
            asm volatile("s_waitcnt vmcnt(0)" ::: "memory");
        }
    }
    __syncthreads();
}

constexpr size_t WS_BAR = 704 * 1024;
constexpr int NPHASE = 17;
__global__ void __launch_bounds__(NTHR, 2) fwd_mega(Args a) {
    extern __shared__ __attribute__((aligned(16))) unsigned char lds[];
    cg::grid_group grid = cg::this_grid();
    const int bid = blockIdx.x, G = gridDim.x;
    const int lo = a.ph_lo, hi = a.ph_hi;
    const float* MOD = (const float*)(a.ws + WS_MOD);
    volatile LAS unsigned* bst = (volatile LAS unsigned*)((LAS unsigned char*)lds + 140032);
    if (threadIdx.x < 2) bst[threadIdx.x] = 0u;
    __syncthreads();
    if (MK_BAR && hi - lo > 1) {
        if (bid == 0) { for (int e = threadIdx.x; e < XCD_BAR_WORDS; e += NTHR) __hip_atomic_store((unsigned*)(a.ws + WS_BAR) + e, 0u, __ATOMIC_RELAXED, __HIP_MEMORY_SCOPE_AGENT); __threadfence(); }
        grid.sync();
    }
    XcdBarrier xbar; xbar.bar = (unsigned*)(a.ws + WS_BAR); xbar.x = 0; xbar.st = bst;
    if (MK_BAR && hi - lo > 1) xbar = xcd_barrier_post((unsigned*)(a.ws + WS_BAR), bst);
    PG8_LAS unsigned char* glds = (PG8_LAS unsigned char*)lds;
#ifndef PH_MASK
#define PH_MASK 0x1ffff
#endif
#define IN(k) (((PH_MASK >> (k)) & 1) && lo <= (k) && (k) < hi)
#define SEAM(k) do { if (IN(k) && IN((k) + 1)) { if (MK_BAR) xcd_barrier(xbar); else grid.sync(); } } while (0)
#define GEMM_PHASE(EPI, EOBJ, Aoff, Boff, N_, K_) do { pg8::Gemm g{(const pg8::bf16_t*)(a.ws + (Aoff)), (const pg8::bf16_t*)(a.ws + (Boff)), TR, (N_), (K_)}; pg8::StaticOrder S; S.init(TR, (N_), G, bid); \
        pg8::gemm_phase<EPI, pg8::StaticOrder, true, true>(glds, g, S, EOBJ); } while (0)

#define GEMM_SPLIT2(Aoff, Boff, K_) do { pg8::Gemm g{(const pg8::bf16_t*)(a.ws + (Aoff)), (const pg8::bf16_t*)(a.ws + (Boff)), TR, 4096, (K_), (K_) / 2, 8}; pg8::StaticOrder S; S.init(TR, 4096, G, bid); \
        pg8::EpiSplit E{(pg8::bf16_t*)(a.ws + WS_F), (pg8::bf16_t*)(a.ws + WS_F2)}; pg8::gemm_phase<pg8::EpiSplit, pg8::StaticOrder, true, true>(glds, g, S, E); } while (0)
    if (IN(0)) { p0_prep(a, lds, bid, G); } SEAM(0);
    if (IN(1)) { p_mod_in(a, bid, G); } SEAM(1);
    if (IN(2)) { pg8::EpiIn E{(pg8::bf16_t*)(a.ws + WS_UG), (pg8::bf16_t*)(a.ws + WS_US)}; GEMM_PHASE(pg8::EpiIn, E, WS_H, WS_WIN, 3072, 2048); } SEAM(2);
    if (IN(3)) { p_s5_conv(a, lds, bid, G); } SEAM(3);
    if (IN(4)) { pg8::EpiGlu E{(const pg8::bf16_t*)(a.ws + WS_YS), (pg8::bf16_t*)(a.ws + WS_CAT)}; GEMM_PHASE(pg8::EpiGlu, E, WS_YS, WS_WGLU, 1024, 1024);
        __syncthreads();
        for (int tk = G - 1 - bid; tk < 384; tk += G) { CONVCALL(conv_tile(a, lds, tk)); } } SEAM(4);
    if (IN(5)) { GEMM_SPLIT2(WS_CAT, WS_WOAB, 2048); } SEAM(5);
    if (IN(6)) { p_ln(a, bid, G, true, MOD + 2 * 2048, a.in[I_LNG], a.in[I_LNB], MOD + 3 * 2048); } SEAM(6);
    if (IN(7)) { pg8::EpiPlain<1> E{(pg8::bf16_t*)(a.ws + WS_A2), 8192}; GEMM_PHASE(pg8::EpiPlain<1>, E, WS_H, WS_WF1, 8192, 2048); } SEAM(7);
    if (IN(8)) { GEMM_SPLIT2(WS_A2, WS_WF2, 8192); } SEAM(8);
    if (IN(9)) { p_ln(a, bid, G, false, MOD + 5 * 2048, a.in[I_LNG] + 2048, a.in[I_LNB] + 2048, MOD + 3 * 12288 + 0 * 2048); } SEAM(9);
    if (IN(10)) { p_cache(a, lds, bid, G);
        pg8::EpiQkv E{(pg8::bf16_t*)(a.ws + WS_QB), (pg8::bf16_t*)(a.ws + WS_KP), (pg8::bf16_t*)(a.ws + WS_VTP), (pg8::bf16_t*)(a.ws + WS_KS), (pg8::bf16_t*)(a.ws + WS_VTS),
                      a.out + OUT_CK, a.out + OUT_CV, (const f32x2*)(a.ws + WS_ROPE)};
        GEMM_PHASE(pg8::EpiQkv, E, WS_H, WS_WQKV, 6144, 2048); } SEAM(10);
    if (IN(11)) { p_attn(a, lds, bid, G); } SEAM(11);
    if (IN(12)) { GEMM_SPLIT2(WS_OA, WS_WOC, 2048); } SEAM(12);
    if (IN(13)) { p_ln(a, bid, G, false, MOD + 3 * 12288 + 2 * 2048, a.in[I_LNG] + 2 * 2048, a.in[I_LNB] + 2 * 2048, MOD + 3 * 12288 + 3 * 2048); } SEAM(13);
    if (IN(14)) { pg8::EpiPlain<1> E{(pg8::bf16_t*)(a.ws + WS_A2), 8192}; GEMM_PHASE(pg8::EpiPlain<1>, E, WS_H, WS_WF1 + (size_t)2048 * 8192 * 2, 8192, 2048); } SEAM(14);
    if (IN(15)) { GEMM_SPLIT2(WS_A2, WS_WF2 + (size_t)2048 * 8192 * 2, 8192); } SEAM(15);
    if (IN(16)) { p_ln(a, bid, G, false, MOD + 3 * 12288 + 5 * 2048, a.in[I_LNG] + 3 * 2048, a.in[I_LNB] + 3 * 2048, nullptr); }
#undef IN
#undef SEAM
#undef GEMM_PHASE
#undef GEMM_SPLIT2
}


#if MK_DIAG
constexpr size_t WS_DIAG = 640 * 1024;
constexpr size_t WS_YSAVE = WS_END;
__device__ __forceinline__ float bf2f(bf16 b) { return __uint_as_float((unsigned)b << 16); }
__device__ __forceinline__ void dmax(float* d, int i, float mine, float ref) { float e = fabsf(mine - ref) / (fabsf(ref) + 0.25f); if (!(e == e)) e = 1e9f; atomicMax((unsigned*)(d + i), __float_as_uint(e)); }
__device__ __forceinline__ float dot_bf(const bf16* arow, int K, const float* W, int ldw, int col) { float s = 0.f; for (int k = 0; k < K; ++k) s += bf2f(arow[k]) * W[(size_t)k * ldw + col]; return s; }
__device__ __forceinline__ int prow(int i) { const int j = i & 7; const int e = j == 0 ? 0 : j == 1 ? 255 : j == 2 ? 256 : j == 3 ? 8191 : j == 4 ? 8192 : j == 5 ? 10239 : j == 6 ? 10240 : 12287; return (i & 8) ? (int)(((unsigned)i * 977u + 13u) % 12288u) : e; }
__global__ void chk_zero(Args a) { ((float*)(a.ws + WS_DIAG))[threadIdx.x] = 0.f; }
__global__ void chk0(Args a) { float* dg = (float*)(a.ws + WS_DIAG); const int i = blockIdx.x * blockDim.x + threadIdx.x; if (i >= 96) return;
    const float* MOD = (const float*)(a.ws + WS_MOD);
    { const int l = i % 2, grp = (i / 2) % 3, col = (int)(((unsigned)i * 131u + 7u) % 12288u); float s = 0.f;
      for (int k = 0; k < 2048; ++k) { const float x = grp == 0 ? a.in[I_CCTX][k] : a.in[I_C][(grp - 1) * 2048 + k]; s += x / (1.f + expf(-x)) * a.in[I_WMOD][((size_t)l * 2048 + k) * 12288 + col]; }
      dmax(dg, 0, MOD[(size_t)(l * 3 + grp) * 12288 + col], s + a.in[I_BMOD][l * 12288 + col]); }
    { const int k = (i * 37) % 2048, n = (int)(((unsigned)i * 131u + 7u) % 3072u); int d = n; if (n < 1024) d = (n >> 7) * 256 + (n & 127); else if (n < 2048) { const int n1 = n - 1024; d = (n1 >> 7) * 256 + 128 + (n1 & 127); }
      dmax(dg, 1, bf2f(((const bf16*)(a.ws + WS_WIN))[(size_t)d * 2048 + k]), a.in[I_WIN][(size_t)k * 3072 + n]); }
    { const int k = (i * 83) % 8192, n = (i * 131 + 7) % 2048; dmax(dg, 2, bf2f(((const bf16*)(a.ws + WS_WF2))[(size_t)2048 * 8192 + (size_t)n * 8192 + k]), a.in[I_WF2][(size_t)2048 * 8192 + (size_t)k * 2048 + n]);
      const int k2 = (i * 37) % 2048; dmax(dg, 2, bf2f(((const bf16*)(a.ws + WS_WF1))[(size_t)2048 * 8192 + (size_t)(n * 4 + 1) * 2048 + k2]), a.in[I_WF1][(size_t)2048 * 8192 + (size_t)k2 * 8192 + n * 4 + 1]);
      dmax(dg, 2, bf2f(((const bf16*)(a.ws + WS_WQKV))[(size_t)(n * 3) * 2048 + k2]), a.in[I_WQKV][(size_t)k2 * 6144 + n * 3]);
      dmax(dg, 2, bf2f(((const bf16*)(a.ws + WS_WOC))[(size_t)n * 2048 + k2]), a.in[I_WOC][(size_t)k2 * 2048 + n] * a.in[I_SUBG][k2 & 127] * (1.f - (0.8f - 0.6f * expf(-0.3f))));
      dmax(dg, 18, bf2f(((const bf16*)(a.ws + WS_WF1))[(size_t)(n * 4 + 1) * 2048 + k2]), a.in[I_WF1][(size_t)k2 * 8192 + n * 4 + 1]);
      dmax(dg, 19, bf2f(((const bf16*)(a.ws + WS_WF2))[(size_t)n * 8192 + k]), a.in[I_WF2][(size_t)k * 2048 + n]);
      dmax(dg, 2, bf2f(((const bf16*)(a.ws + WS_WGLU))[(size_t)(n & 1023) * 1024 + (k2 & 1023)]), a.in[I_WGLU][(size_t)(k2 & 1023) * 1024 + (n & 1023)]);
      dmax(dg, 2, bf2f(((const bf16*)(a.ws + WS_WOAB))[(size_t)n * 2048 + k2]), a.in[I_WOAB][(size_t)k2 * 2048 + n]); }
}
__global__ void chk_in(Args a) { float* dg = (float*)(a.ws + WS_DIAG); const int i = blockIdx.x * blockDim.x + threadIdx.x; if (i >= 64) return;
    const int row = prow(i), c = (int)(((unsigned)i * 131u + 7u) % 1024u); const bf16* h = (const bf16*)(a.ws + WS_H) + (size_t)row * 2048;
    const float val = dot_bf(h, 2048, a.in[I_WIN], 3072, c), gate = dot_bf(h, 2048, a.in[I_WIN], 3072, 1024 + c), u = dot_bf(h, 2048, a.in[I_WIN], 3072, 2048 + c);
    dmax(dg, 3, bf2f(((const bf16*)(a.ws + WS_UG))[(size_t)row * 1024 + c]), val / (1.f + expf(-gate))); dmax(dg, 4, bf2f(((const bf16*)(a.ws + WS_US))[(size_t)row * 1024 + c]), u);
    { const int cc = (i * 131 + 7) % 2048; const float* x = row < TP ? a.in[I_XP] + (size_t)row * DM : a.in[I_XS] + (size_t)(row - TP) * DM; const float* md = (const float*)(a.ws + WS_MOD) + (size_t)row_grp(row) * 12288;
      dmax(dg, 5, bf2f(h[cc]), x[cc] * (1.f + md[2048 + cc]) + md[cc]); }
}
__global__ void chk_s5(Args a) { float* dg = (float*)(a.ws + WS_DIAG); const int i = threadIdx.x; if (i >= 4) return;
    const bool sample = i >= 2; const int dir = i & 1, b = sample ? 1 : 3, g = sample ? 7 : 5, L = sample ? 2048 : 256, row0 = sample ? TP + b * 2048 : b * 256;
    const bf16* US = (const bf16*)(a.ws + WS_US); const float* Yo = (const float*)(a.ws + (dir ? WS_YR : WS_YF)); const int pg = (dir * 64 + g) * 64; const float dt = expf(a.in[I_LDT][dir * 64 + g]);
    float* hr = (float*)(a.ws + WS_YSAVE + 65536) + i * 256; float* hi = hr + 64; float* y = hr + 128;
    for (int n = 0; n < 64; ++n) { hr[n] = 0.f; hi[n] = 0.f; if (sample) { const size_t o = (size_t)((b * 2 + dir) * 64 + g) * 64 + n; hr[n] = a.in[I_SRE][o]; hi[n] = a.in[I_SIM][o]; } }
    for (int t = 0; t < L; ++t) { const int tk = dir ? L - 1 - t : t; for (int p = 0; p < 16; ++p) y[p] = 0.f;
        for (int n = 0; n < 64; ++n) { const float lre = a.in[I_LRE][pg + n], lim = a.in[I_LIM][pg + n], mag = expf(lre * dt), br = mag * cosf(lim * dt), bi = mag * sinf(lim * dt), den = lre * lre + lim * lim;
            const float cr = ((br - 1.f) * lre + bi * lim) / den, ci = (bi * lre - (br - 1.f) * lim) / den; float bur = 0.f, bui = 0.f;
            for (int p = 0; p < 16; ++p) { const float u = bf2f(US[(size_t)(row0 + tk) * 1024 + g * 16 + p]); const float b_r = a.in[I_BRE][(size_t)(pg + n) * 16 + p], b_i = a.in[I_BIM][(size_t)(pg + n) * 16 + p]; bur += u * (cr * b_r - ci * b_i); bui += u * (cr * b_i + ci * b_r); }
            const float nr = br * hr[n] - bi * hi[n] + bur, ni = br * hi[n] + bi * hr[n] + bui; hr[n] = nr; hi[n] = ni;
            for (int p = 0; p < 16; ++p) y[p] += a.in[I_CRE][(size_t)((dir * 64 + g) * 16 + p) * 64 + n] * nr - a.in[I_CIM][(size_t)((dir * 64 + g) * 16 + p) * 64 + n] * ni; }
        for (int p = 0; p < 16; ++p) dmax(dg, 6 + (sample ? 1 : 0), Yo[(size_t)(row0 + tk) * 1024 + g * 16 + p], y[p]); }
    if (!sample) for (int n = 0; n < 64; ++n) { const size_t o = (size_t)((b * 2 + dir) * 64 + g) * 64 + n; dmax(dg, 8, a.out[OUT_SRE + o], hr[n]); dmax(dg, 8, a.out[OUT_SIM + o], hi[n]); }
}
__global__ void chk_ys(Args a) { float* dg = (float*)(a.ws + WS_DIAG); const int i = blockIdx.x * blockDim.x + threadIdx.x; if (i >= 64) return;
    const int row = prow(i), c = (int)(((unsigned)i * 131u + 7u) % 1024u); const size_t o = (size_t)row * 1024 + c;
    const float x = ((const float*)(a.ws + WS_YF))[o] + ((const float*)(a.ws + WS_YR))[o] + a.in[I_S5D][c] * bf2f(((const bf16*)(a.ws + WS_US))[o]);
    const float ge = 0.5f * x * (1.f + tanhf(0.7978845608f * (x + 0.044715f * x * x * x))); dmax(dg, 9, bf2f(((const bf16*)(a.ws + WS_YS))[o]), ge);
}
__global__ void chk_conv(Args a) { float* dg = (float*)(a.ws + WS_DIAG); __shared__ float red[1024]; const int c = threadIdx.x, row = prow(blockIdx.x); int s0, s1;
    if (row < TP) { s0 = row & ~255; s1 = s0 + 256; } else { s0 = TP + ((row - TP) & ~2047); s1 = s0 + 2048; }
    float acc = a.in[I_BDW][c]; for (int k = 0; k < 31; ++k) { const int r = row + k - 15; if (r >= s0 && r < s1) acc += a.in[I_WDW][k * 1024 + c] * bf2f(((const bf16*)(a.ws + WS_UG))[(size_t)r * 1024 + c]); }
    red[c] = acc; __syncthreads(); float m = 0.f; for (int j = 0; j < 1024; ++j) m += red[j]; m /= 1024.f; float v = 0.f; for (int j = 0; j < 1024; ++j) v += (red[j] - m) * (red[j] - m); v /= 1024.f;
    float y = (acc - m) / sqrtf(v + LN_EPS) * a.in[I_CLNG][c] + a.in[I_CLNB][c]; y = y / (1.f + expf(-y)); dmax(dg, 10, bf2f(((const bf16*)(a.ws + WS_CAT))[(size_t)row * 2048 + c]), y);
}
__global__ void chk_glu(Args a) { float* dg = (float*)(a.ws + WS_DIAG); const int i = blockIdx.x * blockDim.x + threadIdx.x; if (i >= 64) return;
    const int row = prow(i), c = (int)(((unsigned)i * 131u + 7u) % 1024u); const bf16* ys = (const bf16*)(a.ws + WS_YS) + (size_t)row * 1024; const float g = dot_bf(ys, 1024, a.in[I_WGLU], 1024, c);
    dmax(dg, 11, bf2f(((const bf16*)(a.ws + WS_CAT))[(size_t)row * 2048 + 1024 + c]), bf2f(ys[c]) / (1.f + expf(-g)));
}
__global__ void chk_proj(Args a, size_t aoff, int K, const float* W, int slot, int scaled) { float* dg = (float*)(a.ws + WS_DIAG); const int i = blockIdx.x * blockDim.x + threadIdx.x; if (i >= 64) return;
    const int row = prow(i), c = (int)(((unsigned)i * 131u + 7u) % 2048u); const bf16* ar = (const bf16*)(a.ws + aoff) + (size_t)row * K; float s = 0.f;
    for (int k = 0; k < K; ++k) { float w = W[(size_t)k * 2048 + c]; if (scaled) w *= a.in[I_SUBG][k & 127] * (1.f - (0.8f - 0.6f * expf(-0.3f))); s += bf2f(ar[k]) * w; }
    dmax(dg, slot, bf2f(((const bf16*)(a.ws + WS_F))[(size_t)row * 2048 + c]), s);
}
__global__ void chk_ff1(Args a, const float* W, int slot) { float* dg = (float*)(a.ws + WS_DIAG); const int i = blockIdx.x * blockDim.x + threadIdx.x; if (i >= 64) return;
    const int row = prow(i), c = (int)(((unsigned)i * 131u + 7u) % 8192u); const bf16* h = (const bf16*)(a.ws + WS_H) + (size_t)row * 2048; float s = fmaxf(dot_bf(h, 2048, W, 8192, c), 0.f);
    dmax(dg, slot == 14 ? 33 + (i & 7) : slot, bf2f(((const bf16*)(a.ws + WS_A2))[(size_t)row * 8192 + c]), s * s);
    if (slot == 14) { const int k2 = (i * 37) % 2048; dmax(dg, 32, bf2f(((const bf16*)(a.ws + WS_WF1))[(size_t)c * 2048 + k2]), W[(size_t)k2 * 8192 + c]); }
}
__global__ void chk_save(Args a) { const int r = blockIdx.x; for (int c = threadIdx.x; c < 2048; c += blockDim.x) ((float*)(a.ws + WS_YSAVE))[r * 2048 + c] = a.out[OUT_Y + (size_t)prow(r) * 2048 + c]; }
__global__ void chk_ln(Args a, int first, int l, int which, int slot) { float* dg = (float*)(a.ws + WS_DIAG); __shared__ float red[2048]; const int r = blockIdx.x, row = prow(r), grp = row_grp(row);
    const float* MOD = (const float*)(a.ws + WS_MOD) + (size_t)(l * 3 + grp) * 12288; const float* x = first ? (row < TP ? a.in[I_XP] + (size_t)row * DM : a.in[I_XS] + (size_t)(row - TP) * DM) : (const float*)(a.ws + WS_YSAVE) + r * 2048;
    for (int c = threadIdx.x; c < 2048; c += blockDim.x) red[c] = ALPHA * x[c] + MOD[(which ? 5 : 2) * 2048 + c] * bf2f(((const bf16*)(a.ws + WS_F))[(size_t)row * 2048 + c]);
    __syncthreads(); float m = 0.f; for (int j = 0; j < 2048; ++j) m += red[j]; m /= 2048.f; float v = 0.f; for (int j = 0; j < 2048; ++j) v += (red[j] - m) * (red[j] - m); v /= 2048.f;
    for (int c = threadIdx.x; c < 2048; c += blockDim.x) { const float y = (red[c] - m) / sqrtf(v + LN_EPS) * a.in[I_LNG][(l * 2 + which) * 2048 + c] + a.in[I_LNB][(l * 2 + which) * 2048 + c];
        dmax(dg, slot, a.out[OUT_Y + (size_t)row * 2048 + c], y);
        if (!(l == 1 && which == 1)) { const float* nm = which ? (const float*)(a.ws + WS_MOD) + (size_t)((l + 1) * 3 + grp) * 12288 : MOD + 3 * 2048; dmax(dg, slot, bf2f(((const bf16*)(a.ws + WS_H))[(size_t)row * 2048 + c]), y * (1.f + nm[2048 + c]) + nm[c]); } }
}
__global__ void chk_qkv(Args a) { float* dg = (float*)(a.ws + WS_DIAG); const int i = blockIdx.x * blockDim.x + threadIdx.x; if (i >= 64) return;
    const int row = prow(i); const bool sample = row >= TP; const int s = sample ? (row - TP) & 2047 : row & 255, bb = sample ? (row - TP) >> 11 : row >> 8; const bf16* h = (const bf16*)(a.ws + WS_H) + (size_t)row * 2048;
    const int col = (int)(((unsigned)i * 131u + 7u) % 2048u), mm = col >> 10, hh = (col >> 6) & 15, d = col & 63;
    for (int which = 0; which < 2; ++which) { float v = dot_bf(h, 2048, a.in[I_WQKV], 6144, which * 2048 + col);
        if (sample) { const int seg = d >> 5, ii = d & 15, second = (d >> 4) & 1; const float pos = seg ? (float)(s & 63) : (float)(s >> 6); const float ang = pos * powf(10000.f, -(float)ii / 16.f);
            const float other = dot_bf(h, 2048, a.in[I_WQKV], 6144, which * 2048 + (second ? col - 16 : col + 16)); v = second ? other * sinf(ang) + v * cosf(ang) : v * cosf(ang) - other * sinf(ang); }
        if (which == 0) dmax(dg, 20, bf2f(((const bf16*)(a.ws + WS_QB))[(size_t)row * 2048 + col]), v * QSCALE);
        else if (sample) dmax(dg, 21, bf2f(((const bf16*)(a.ws + WS_KS))[((size_t)((bb * 2 + mm) * 16 + hh) * 2560 + s) * 64 + d]), v);
        else { const size_t o = ((size_t)((bb * 2 + mm) * 16 + hh) * 256 + s) * 64 + d; dmax(dg, 21, bf2f(((const bf16*)(a.ws + WS_KP))[o]), v); dmax(dg, 22, a.out[OUT_CK + o], v); } }
    { const int hv = col >> 7, dv = col & 127; const float v = dot_bf(h, 2048, a.in[I_WQKV], 6144, 4096 + col);
      if (sample) dmax(dg, 23, bf2f(((const bf16*)(a.ws + WS_VTS))[((size_t)(bb * 16 + hv) * 128 + dv) * 2560 + s]), v);
      else { dmax(dg, 23, bf2f(((const bf16*)(a.ws + WS_VTP))[((size_t)(bb * 16 + hv) * 128 + dv) * 256 + s]), v); dmax(dg, 24, a.out[OUT_CV + ((size_t)(bb * 16 + hv) * 256 + s) * 128 + dv], v); } }
    { const int bmh = i, j = (i * 37) % 512, dd = (i * 11) % 64; dmax(dg, 25, bf2f(((const bf16*)(a.ws + WS_KS))[((size_t)bmh * 2560 + 2048 + j) * 64 + dd]), a.in[I_CK][((size_t)bmh * 512 + j) * 64 + dd]);
      const int bh = i & 31, dv2 = (i * 29) % 128; dmax(dg, 25, bf2f(((const bf16*)(a.ws + WS_VTS))[((size_t)bh * 128 + dv2) * 2560 + 2048 + j]), a.in[I_CV][((size_t)bh * 512 + j) * 128 + dv2]); }
}
__global__ void chk_attn(Args a) { float* dg = (float*)(a.ws + WS_DIAG); const int i = blockIdx.x * blockDim.x + threadIdx.x; if (i >= 32) return;
    const int row = prow(i), hh = (i * 5) % 16; const bool sample = row >= TP; const int bb = sample ? (row - TP) >> 11 : row >> 8, nk = sample ? 2560 : 256;
    const bf16* q = (const bf16*)(a.ws + WS_QB) + (size_t)row * 2048 + hh * 64; float* o = (float*)(a.ws + WS_YSAVE + 65536 + 8192) + i * 128; for (int d = 0; d < 128; ++d) o[d] = 0.f;
    float d1 = 0.f, d2 = 0.f; for (int j = 0; j < 64; ++j) { d1 += a.in[I_LQ1][j] * a.in[I_LK1][j]; d2 += a.in[I_LQ2][j] * a.in[I_LK2][j]; } const float lam = expf(d1) - expf(d2) + 0.8f - 0.6f * expf(-0.3f);
    const bf16* VT = sample ? (const bf16*)(a.ws + WS_VTS) + (size_t)(bb * 16 + hh) * 128 * 2560 : (const bf16*)(a.ws + WS_VTP) + (size_t)(bb * 16 + hh) * 128 * 256;
    for (int m = 0; m < 2; ++m) { const bf16* K = sample ? (const bf16*)(a.ws + WS_KS) + (size_t)((bb * 2 + m) * 16 + hh) * 2560 * 64 : (const bf16*)(a.ws + WS_KP) + (size_t)((bb * 2 + m) * 16 + hh) * 256 * 64;
        float mx = -1e30f; for (int k = 0; k < nk; ++k) { float s = 0.f; for (int d = 0; d < 64; ++d) s += bf2f(q[m * 1024 + d]) * bf2f(K[(size_t)k * 64 + d]); mx = fmaxf(mx, s); }
        float l = 0.f; for (int k = 0; k < nk; ++k) { float s = 0.f; for (int d = 0; d < 64; ++d) s += bf2f(q[m * 1024 + d]) * bf2f(K[(size_t)k * 64 + d]); l += exp2f(s - mx); }
        for (int k = 0; k < nk; ++k) { float s = 0.f; for (int d = 0; d < 64; ++d) s += bf2f(q[m * 1024 + d]) * bf2f(K[(size_t)k * 64 + d]); const float p = exp2f(s - mx) / l * (m ? -lam : 1.f);
            for (int d = 0; d < 128; ++d) o[d] += p * bf2f(VT[(size_t)d * nk + k]); } }
    float ss = 0.f; for (int d = 0; d < 128; ++d) ss += o[d] * o[d]; const float ri = 1.f / sqrtf(ss / 128.f + LN_EPS);
    for (int d = 0; d < 128; ++d) dmax(dg, 26, bf2f(((const bf16*)(a.ws + WS_OA))[(size_t)row * 2048 + hh * 128 + d]), o[d] * ri);
}
__global__ void chk_report(Args a) { const float* dg = (const float*)(a.ws + WS_DIAG); if (threadIdx.x == 0 && blockIdx.x == 0) { for (int i = 0; i < 48; ++i) if (dg[i] > 0.04f) { a.out[0] = 100.f * (float)(i + 1); break; } } }
#endif

#if MK_DET
#ifndef DET_PH
#define DET_PH 17
#endif
__global__ void det_sum(const unsigned* A, size_t n, unsigned long long* res) { size_t i = (size_t)blockIdx.x * blockDim.x + threadIdx.x; unsigned long long s = 0;
    for (; i < n; i += (size_t)gridDim.x * blockDim.x) s += (unsigned long long)A[i] * (unsigned long long)((i & 1023) + 1);
    atomicAdd(res, s); }
__global__ void det_zero(unsigned long long* res) { res[threadIdx.x] = 0ull; }
__global__ void det_rep(float* out, const unsigned long long* res) { if (res[0] != res[1]) out[0] = 1000.f; }
#endif
extern "C" void kernel_launch(void* const* d_in, const int* in_sizes, int n_in, void* d_out, int out_size, void* d_ws, size_t ws_size, hipStream_t stream) {
    static int grid = 0;
    if (grid == 0) {
        if (n_in != 36 || ws_size < WS_END) { fprintf(stderr, "kernel_launch: unexpected n_in %d / ws_size %zu\n", n_in, ws_size); grid = -1; return; }
        int dev = 0, cus = 0, per_cu = 0;
        if (hipGetDevice(&dev) != hipSuccess || hipDeviceGetAttribute(&cus, hipDeviceAttributeMultiprocessorCount, dev) != hipSuccess) { grid = -1; return; }
        if (hipFuncSetAttribute((const void*)fwd_mega, hipFuncAttributeMaxDynamicSharedMemorySize, LDS_BYTES) != hipSuccess) { fprintf(stderr, "kernel_launch: hipFuncSetAttribute failed\n"); grid = -1; return; }
        if (hipOccupancyMaxActiveBlocksPerMultiprocessor(&per_cu, (const void*)fwd_mega, NTHR, LDS_BYTES) != hipSuccess || per_cu < 1) { fprintf(stderr, "kernel_launch: occupancy query says %d\n", per_cu); per_cu = 1; }
        (void)hipGetLastError();
        grid = cus * 1;
    }
    if (grid < 0) return;
    if (hipMemsetAsync((char*)d_ws + WS_BAR, 0, XCD_BAR_WORDS * 4, stream) != hipSuccess) { fprintf(stderr, "kernel_launch: memset of barrier words failed\n"); return; }
    Args a{};
    for (int i = 0; i < 36; ++i) a.in[i] = (const float*)d_in[i];
    a.out = (float*)d_out; a.ws = (unsigned char*)d_ws;
#if MK_MULTI
#if MK_DIAG
    {  void* ca[] = {&a}; hipLaunchCooperativeKernel((const void*)chk_zero, dim3(1), dim3(64), ca, 0, stream); }
#endif
    for (int ph = 0; ph < NPHASE; ++ph) { a.ph_lo = ph; a.ph_hi = ph + 1; void* args[] = {&a};
#if MK_DIAG
        if (ph == 9 || ph == 13 || ph == 16) {  void* ca[] = {&a}; hipLaunchCooperativeKernel((const void*)chk_save, dim3(8), dim3(256), ca, 0, stream); }
#endif
        hipError_t e = hipLaunchCooperativeKernel((const void*)fwd_mega, dim3(grid), dim3(NTHR), args, LDS_BYTES, stream);
        if (e != hipSuccess) { fprintf(stderr, "launch %d failed: %s\n", ph, hipGetErrorString(e)); break; }
#if MK_DIAG
        const float* in_[36]; for (int i = 0; i < 36; ++i) in_[i] = (const float*)d_in[i];
        if (ph == 0) {  void* ca[] = {&a}; hipLaunchCooperativeKernel((const void*)chk0, dim3(1), dim3(128), ca, 0, stream); }
        if (ph == 2) {  void* ca[] = {&a}; hipLaunchCooperativeKernel((const void*)chk_in, dim3(1), dim3(64), ca, 0, stream); }
        if (ph == 3) { {  void* ca[] = {&a}; hipLaunchCooperativeKernel((const void*)chk_s5, dim3(1), dim3(64), ca, 0, stream); } {  void* ca[] = {&a}; hipLaunchCooperativeKernel((const void*)chk_ys, dim3(1), dim3(64), ca, 0, stream); } {  void* ca[] = {&a}; hipLaunchCooperativeKernel((const void*)chk_conv, dim3(16), dim3(1024), ca, 0, stream); } }
        if (ph == 4) {  void* ca[] = {&a}; hipLaunchCooperativeKernel((const void*)chk_glu, dim3(1), dim3(64), ca, 0, stream); }
        if (ph == 5) { auto v1 = WS_CAT; auto v2 = 2048; auto v3 = in_[I_WOAB]; auto v4 = 12; auto v5 = 0; void* ca[] = {&a, &v1, &v2, &v3, &v4, &v5}; hipLaunchCooperativeKernel((const void*)chk_proj, dim3(1), dim3(64), ca, 0, stream); }
        if (ph == 6) { auto v1 = 1; auto v2 = 0; auto v3 = 0; auto v4 = 13; void* ca[] = {&a, &v1, &v2, &v3, &v4}; hipLaunchCooperativeKernel((const void*)chk_ln, dim3(8), dim3(256), ca, 0, stream); }
        if (ph == 7) { auto v1 = in_[I_WF1]; auto v2 = 14; void* ca[] = {&a, &v1, &v2}; hipLaunchCooperativeKernel((const void*)chk_ff1, dim3(1), dim3(64), ca, 0, stream); }
        if (ph == 8) { auto v1 = WS_A2; auto v2 = 8192; auto v3 = in_[I_WF2]; auto v4 = 15; auto v5 = 0; void* ca[] = {&a, &v1, &v2, &v3, &v4, &v5}; hipLaunchCooperativeKernel((const void*)chk_proj, dim3(1), dim3(64), ca, 0, stream); }
        if (ph == 9) { auto v1 = 0; auto v2 = 0; auto v3 = 1; auto v4 = 16; void* ca[] = {&a, &v1, &v2, &v3, &v4}; hipLaunchCooperativeKernel((const void*)chk_ln, dim3(8), dim3(256), ca, 0, stream); }
        if (ph == 10) {  void* ca[] = {&a}; hipLaunchCooperativeKernel((const void*)chk_qkv, dim3(1), dim3(64), ca, 0, stream); }
        if (ph == 11) {  void* ca[] = {&a}; hipLaunchCooperativeKernel((const void*)chk_attn, dim3(1), dim3(64), ca, 0, stream); }
        if (ph == 12) { auto v1 = WS_OA; auto v2 = 2048; auto v3 = in_[I_WOC]; auto v4 = 27; auto v5 = 1; void* ca[] = {&a, &v1, &v2, &v3, &v4, &v5}; hipLaunchCooperativeKernel((const void*)chk_proj, dim3(1), dim3(64), ca, 0, stream); }
        if (ph == 13) { auto v1 = 0; auto v2 = 1; auto v3 = 0; auto v4 = 28; void* ca[] = {&a, &v1, &v2, &v3, &v4}; hipLaunchCooperativeKernel((const void*)chk_ln, dim3(8), dim3(256), ca, 0, stream); }
        if (ph == 14) { auto v1 = in_[I_WF1] + (size_t)2048 * 8192; auto v2 = 29; void* ca[] = {&a, &v1, &v2}; hipLaunchCooperativeKernel((const void*)chk_ff1, dim3(1), dim3(64), ca, 0, stream); }
        if (ph == 15) { auto v1 = WS_A2; auto v2 = 8192; auto v3 = in_[I_WF2] + (size_t)2048 * 8192; auto v4 = 30; auto v5 = 0; void* ca[] = {&a, &v1, &v2, &v3, &v4, &v5}; hipLaunchCooperativeKernel((const void*)chk_proj, dim3(1), dim3(64), ca, 0, stream); }
        if (ph == 16) { { auto v1 = 0; auto v2 = 1; auto v3 = 1; auto v4 = 31; void* ca[] = {&a, &v1, &v2, &v3, &v4}; hipLaunchCooperativeKernel((const void*)chk_ln, dim3(8), dim3(256), ca, 0, stream); } {  void* ca[] = {&a}; hipLaunchCooperativeKernel((const void*)chk_report, dim3(1), dim3(64), ca, 0, stream); } }
#endif
    }
#else
    a.ph_lo = 0; a.ph_hi = NPHASE; void* args[] = {&a};
#if MK_DET
    { unsigned long long* res = (unsigned long long*)((char*)d_ws + 768 * 1024); a.ph_hi = DET_PH;
      { void* c0[] = {&res}; hipLaunchCooperativeKernel((const void*)det_zero, dim3(1), dim3(8), c0, 0, stream); }
      for (int rep = 0; rep < 2; ++rep) {
        a.ph_lo = 0; a.ph_hi = DET_PH; hipLaunchCooperativeKernel((const void*)fwd_mega, dim3(grid), dim3(NTHR), args, LDS_BYTES, stream);
        unsigned long long* r = res + rep;
        { const unsigned* p = (const unsigned*)d_ws; size_t n = (640 * 1024) / 4; void* c1[] = {&p, &n, &r}; hipLaunchCooperativeKernel((const void*)det_sum, dim3(64), dim3(256), c1, 0, stream); }
        { const unsigned* p = (const unsigned*)((char*)d_ws + DET_LO); size_t n = (DET_HI - DET_LO) / 4; void* c1[] = {&p, &n, &r}; hipLaunchCooperativeKernel((const void*)det_sum, dim3(2048), dim3(256), c1, 0, stream); }
        if (!DET_NO_OUT) { const unsigned* p = (const unsigned*)d_out; size_t n = (size_t)out_size; void* c1[] = {&p, &n, &r}; hipLaunchCooperativeKernel((const void*)det_sum, dim3(2048), dim3(256), c1, 0, stream); }
      }
      { float* po = (float*)d_out; const unsigned long long* pr = res; void* c2[] = {&po, &pr}; hipLaunchCooperativeKernel((const void*)det_rep, dim3(1), dim3(1), c2, 0, stream); }
      return; }
#endif
    hipError_t e = hipLaunchCooperativeKernel((const void*)fwd_mega, dim3(grid), dim3(NTHR), args, LDS_BYTES, stream);
    if (e != hipSuccess) fprintf(stderr, "cooperative launch failed: %s (grid %d)\n", hipGetErrorString(e), grid);
#endif
}
```

```cpp
#include <hip/hip_runtime.h>
#include <hip/hip_cooperative_groups.h>
#include <cstdio>
#include <cstdint>
namespace cg = cooperative_groups;
namespace pg8 {
#define PG8_LAS __attribute__((address_space(3)))
typedef unsigned short bf16_t;
typedef short bf16x8 __attribute__((ext_vector_type(8)));
typedef float f32x4 __attribute__((ext_vector_type(4)));
typedef unsigned u32x4 __attribute__((ext_vector_type(4)));
constexpr int BM = 256, BK = 64, HALF = 128, HTB = HALF * BK * 2  , STAGE_BYTES = 8 * HTB, NXCD = 8, WGM = 8;

__host__ __device__ __forceinline__ int lds_byte(int r, int c) { const int st = (r >> 4) * 2 + (c >> 5), rr = r & 15, cc = c & 31, ob = rr * 64 + cc * 2; return st * 1024 + (ob ^ (((ob >> 9) & 1) << 5)); }
__host__ __device__ __forceinline__ void stage_rc(int b, int& R, int& C) { const int st = b / 1024, sb = b % 1024, swz = sb ^ (((sb >> 9) & 1) << 5); R = (st >> 1) * 16 + swz / 64; C = (st & 1) * 32 + (swz % 64) / 2; }
__host__ __device__ __forceinline__ int perm32(int rho) { const int n = rho >> 4, i = rho & 15; return 8 * (i >> 2) + 4 * n + (i & 3); }

struct Unit { int pm, pn; };
struct Gemm { const bf16_t* A; const bf16_t* Bt; int M, N, K; int KS = 0, NT = 0; };

struct StaticOrder {
    int nM, nN, nwg, G, c;
    __host__ __device__ void init(int M, int N, int G_, int c_) { nM = M / BM; nN = N / BM; nwg = nM * nN; G = G_; c = c_; }
    __host__ __device__ bool next(int i, Unit& u) const {
        const long L = (long)i * G + c; if (L >= nwg) return false;
        int wgid = (int)L; { const int q = nwg / NXCD, r = nwg % NXCD, xcd = wgid % NXCD, off = wgid / NXCD; wgid = (xcd < r ? xcd * (q + 1) : r * (q + 1) + (xcd - r) * q) + off; }
        const int nig = WGM * nN, gid = wgid / nig, fm = gid * WGM, gsz = (nM - fm) < WGM ? (nM - fm) : WGM;
        u.pm = fm + ((wgid % nig) % gsz); u.pn = (wgid % nig) / gsz; return true;
    }
    __device__ __forceinline__ void a_ready(const Unit&) const {}
    __device__ __forceinline__ void done(const Unit&) const {}
};

__device__ __forceinline__ unsigned cvt_pk_bf16(float lo, float hi) { unsigned r; asm volatile("v_cvt_pk_bf16_f32 %0, %1, %2" : "=v"(r) : "v"(lo), "v"(hi)); return r; }
typedef float f32x2 __attribute__((ext_vector_type(2)));
template <class Epi, class Sched, bool ALIGN_EPI = false, bool SP2 = false>
__device__ __forceinline__ void gemm_phase(PG8_LAS unsigned char* lds, const Gemm g, const Sched& S, const Epi& E) {
    const int tid = threadIdx.x, wid = __builtin_amdgcn_readfirstlane(tid >> 6), lane = tid & 63, wr = wid >> 2, wc = wid & 3, fr = lane & 15, fq = lane >> 4;
    const int K = g.K, nt = (g.KS ? g.KS : K) / BK;
    const int NTs = g.NT ? g.NT : (1 << 20); const size_t ksl = (size_t)g.KS * 2;
    unsigned voffA[2], voffB[2];
#pragma unroll
    for (int i = 0; i < 2; ++i) { int R, C; stage_rc(tid * 16 + i * 8192, R, C); const int Rb = Epi::PERM ? ((R & ~31) + perm32(R & 31)) : R;
        voffA[i] = (unsigned)(R * K + C) * 2u; voffB[i] = (unsigned)(Rb * K + C) * 2u; }
    const size_t kstep = (size_t)(BK * 2);
    const size_t hstep = (size_t)HALF * K * 2;
    const size_t tstep = 2 * hstep;
    const unsigned ldsw = (unsigned)wid * 1024u;
    const int aoff = lds_byte(wr * 64 + fr, fq * 8), boff = lds_byte(wc * 32 + fr, fq * 8);
#define PG8_SA(b, h) (((b) * 2 + (h)) * HTB)
#define PG8_SB(b, h) ((4 + (b) * 2 + (h)) * HTB)
#define PG8_STAGE(bufoff, gbase, voff) do { _Pragma("unroll") for (int _i = 0; _i < 2; ++_i) \
        __builtin_amdgcn_global_load_lds((const unsigned*)((const char*)(gbase) + (voff)[_i]), (PG8_LAS unsigned*)(lds + (bufoff) + ldsw + _i * 8192), 16, 0, 0); } while (0)
#define PG8_LDA(dst, b, h) do { _Pragma("unroll") for (int m = 0; m < 4; ++m) _Pragma("unroll") for (int k = 0; k < 2; ++k) dst[m][k] = *(const PG8_LAS bf16x8*)(lds + PG8_SA(b, h) + aoff + m * 2048 + k * 1024); } while (0)
#define PG8_LDB(dst, b, h) do { _Pragma("unroll") for (int n = 0; n < 2; ++n) _Pragma("unroll") for (int k = 0; k < 2; ++k) dst[n][k] = *(const PG8_LAS bf16x8*)(lds + PG8_SB(b, h) + boff + n * 2048 + k * 1024); } while (0)
#define PG8_MMA(ai, bj, At, Bt) do { __builtin_amdgcn_s_setprio(1); _Pragma("unroll") for (int m = 0; m < 4; ++m) _Pragma("unroll") for (int n = 0; n < 2; ++n) _Pragma("unroll") for (int k = 0; k < 2; ++k) \
        acc[ai][bj][m][n] = __builtin_amdgcn_mfma_f32_16x16x32_bf16(Bt[n][k], At[m][k], acc[ai][bj][m][n], 0, 0, 0); __builtin_amdgcn_s_setprio(0); } while (0)
#define PG8_WAIT_V(n) asm volatile("s_waitcnt vmcnt(" #n ")" ::: "memory")
#define PG8_WAIT_L(n) asm volatile("s_waitcnt lgkmcnt(" #n ")" ::: "memory")
#define PG8_BAR __builtin_amdgcn_s_barrier()
#define PG8_SCHED __builtin_amdgcn_sched_barrier(0)
    Unit cur, nxt; int ui = 0;
    if (!S.next(0, cur)) return;
    f32x4 acc[2][2][4][2];
#pragma unroll
    for (int a = 0; a < 2; ++a)
#pragma unroll
        for (int b = 0; b < 2; ++b)
#pragma unroll
            for (int m = 0; m < 4; ++m)
#pragma unroll
                for (int n = 0; n < 2; ++n) acc[a][b][m][n] = (f32x4){0.f, 0.f, 0.f, 0.f};
    bf16x8 At[4][2], B0[2][2], B1[2][2];
    const char* cA = (const char*)g.A + (size_t)cur.pm * tstep + (size_t)(cur.pn / NTs) * ksl; const char* cB = (const char*)g.Bt + (size_t)(cur.pn % NTs) * tstep + (size_t)(cur.pn / NTs) * ksl;
    S.a_ready(cur);
    if constexpr (SP2) {
        PG8_STAGE(PG8_SB(0, 0), cB, voffB); PG8_STAGE(PG8_SB(0, 1), cB + hstep, voffB); PG8_STAGE(PG8_SA(0, 0), cA, voffA); PG8_STAGE(PG8_SA(0, 1), cA + hstep, voffA);
        if (wr == 1) PG8_BAR;
        PG8_WAIT_V(2); PG8_BAR;
        PG8_STAGE(PG8_SB(1, 0), cB + kstep, voffB); PG8_STAGE(PG8_SA(1, 0), cA + kstep, voffA); PG8_STAGE(PG8_SB(1, 1), cB + hstep + kstep, voffB);
        PG8_WAIT_V(6); PG8_BAR;
    } else {
        PG8_STAGE(PG8_SB(0, 0), cB, voffB); PG8_STAGE(PG8_SA(0, 0), cA, voffA); PG8_STAGE(PG8_SB(0, 1), cB + hstep, voffB); PG8_STAGE(PG8_SA(0, 1), cA + hstep, voffA);
        if (wr == 1) PG8_BAR;
        PG8_WAIT_V(4); PG8_BAR;
        PG8_STAGE(PG8_SB(1, 0), cB + kstep, voffB); PG8_STAGE(PG8_SA(1, 0), cA + kstep, voffA); PG8_STAGE(PG8_SB(1, 1), cB + hstep + kstep, voffB);
        PG8_WAIT_V(6); PG8_BAR;
    }
    for (;;) {
        const bool has_next = S.next(ui + 1, nxt);
        const char* nA = has_next ? (const char*)g.A + (size_t)nxt.pm * tstep + (size_t)(nxt.pn / NTs) * ksl : cA; const char* nB = has_next ? (const char*)g.Bt + (size_t)(nxt.pn % NTs) * tstep + (size_t)(nxt.pn / NTs) * ksl : cB;
        for (int t = 0; t < nt; t += 2) {
            const bool last = (t == nt - 2);
            const char* a1 = cA + (size_t)(t + 1) * kstep;
            const char* a2 = last ? nA : cA + (size_t)(t + 2) * kstep; const char* b2 = last ? nB : cB + (size_t)(t + 2) * kstep;
            const char* a3 = a2 + kstep; const char* b3 = b2 + kstep;
            if (last && has_next) S.a_ready(nxt);
            if constexpr (SP2) {
            PG8_LDB(B0, 0, 0); PG8_LDB(B1, 0, 1); PG8_SCHED; PG8_LDA(At, 0, 0); PG8_STAGE(PG8_SA(1, 1), a1 + hstep, voffA);
            PG8_WAIT_V(8); PG8_WAIT_L(0); PG8_BAR; PG8_MMA(0, 0, At, B0); PG8_MMA(0, 1, At, B1); PG8_BAR; PG8_SCHED;
            PG8_LDA(At, 0, 1); PG8_STAGE(PG8_SB(0, 0), b2, voffB); PG8_STAGE(PG8_SB(0, 1), b2 + hstep, voffB); PG8_STAGE(PG8_SA(0, 0), a2, voffA);
            PG8_WAIT_V(8); PG8_WAIT_L(0); PG8_BAR; PG8_MMA(1, 0, At, B0); PG8_MMA(1, 1, At, B1); PG8_BAR; PG8_SCHED;
            PG8_LDB(B0, 1, 0); PG8_LDB(B1, 1, 1); PG8_SCHED; PG8_LDA(At, 1, 0); PG8_STAGE(PG8_SA(0, 1), a2 + hstep, voffA);
            PG8_WAIT_V(8); PG8_WAIT_L(0); PG8_BAR; PG8_MMA(0, 0, At, B0); PG8_MMA(0, 1, At, B1); PG8_BAR; PG8_SCHED;
            PG8_LDA(At, 1, 1); PG8_STAGE(PG8_SB(1, 0), b3, voffB); PG8_STAGE(PG8_SB(1, 1), b3 + hstep, voffB); PG8_STAGE(PG8_SA(1, 0), a3, voffA);
            PG8_WAIT_V(8); PG8_WAIT_L(0); PG8_BAR; PG8_MMA(1, 0, At, B0); PG8_MMA(1, 1, At, B1); PG8_BAR; PG8_SCHED;
            } else {
            PG8_LDB(B0, 0, 0); PG8_SCHED; PG8_LDA(At, 0, 0); PG8_STAGE(PG8_SA(1, 1), a1 + hstep, voffA);
            PG8_WAIT_L(8); PG8_BAR; PG8_WAIT_L(0); PG8_MMA(0, 0, At, B0); PG8_BAR; PG8_SCHED;
            PG8_LDB(B1, 0, 1); PG8_STAGE(PG8_SB(0, 0), b2, voffB);
            PG8_BAR; PG8_WAIT_L(0); PG8_MMA(0, 1, At, B1); PG8_BAR;
            PG8_LDA(At, 0, 1); PG8_STAGE(PG8_SA(0, 0), a2, voffA);
            PG8_BAR; PG8_WAIT_L(0); PG8_MMA(1, 0, At, B0); PG8_BAR; PG8_SCHED;
            PG8_STAGE(PG8_SB(0, 1), b2 + hstep, voffB);
            PG8_WAIT_V(6); PG8_BAR; PG8_MMA(1, 1, At, B1); PG8_BAR;
            PG8_LDB(B0, 1, 0); PG8_SCHED; PG8_LDA(At, 1, 0); PG8_STAGE(PG8_SA(0, 1), a2 + hstep, voffA);
            PG8_WAIT_L(8); PG8_BAR; PG8_WAIT_L(0); PG8_MMA(0, 0, At, B0); PG8_BAR; PG8_SCHED;
            PG8_LDB(B1, 1, 1); PG8_STAGE(PG8_SB(1, 0), b3, voffB);
            PG8_BAR; PG8_WAIT_L(0); PG8_MMA(0, 1, At, B1); PG8_BAR;
            PG8_LDA(At, 1, 1); PG8_STAGE(PG8_SA(1, 0), a3, voffA);
            PG8_BAR; PG8_WAIT_L(0); PG8_MMA(1, 0, At, B0); PG8_BAR; PG8_SCHED;
            PG8_STAGE(PG8_SB(1, 1), b3 + hstep, voffB);
            PG8_WAIT_V(6); PG8_BAR; PG8_MMA(1, 1, At, B1); PG8_BAR;
            }
        }
        if constexpr (ALIGN_EPI) { if (wr == 0) PG8_BAR; }
        asm volatile("s_nop 15\n\ts_nop 15" : "+v"(acc[1][1][3][1]), "+v"(acc[1][1][3][0]), "+v"(acc[1][0][3][1]), "+v"(acc[1][1][2][1]));
        if constexpr (!Epi::AFTER_DRAIN) { E(acc, cur, wr, wc, fr, fq); S.done(cur); }
        if (!has_next) break;
#pragma unroll
        for (int a = 0; a < 2; ++a)
#pragma unroll
            for (int b = 0; b < 2; ++b)
#pragma unroll
                for (int m = 0; m < 4; ++m)
#pragma unroll
                    for (int n = 0; n < 2; ++n) acc[a][b][m][n] = (f32x4){0.f, 0.f, 0.f, 0.f};
        cur = nxt; cA = nA; cB = nB; ++ui;
        if constexpr (ALIGN_EPI) { if (wr == 1) PG8_BAR; }
    }
    PG8_WAIT_V(0);
    if constexpr (!ALIGN_EPI) { if (wr == 0) PG8_BAR; }
    PG8_BAR;
    if constexpr (Epi::AFTER_DRAIN) { E.fused(acc, cur, wr, wc, fr, fq, lds, wid, lane); S.done(cur); }
#undef PG8_SA
#undef PG8_SB
#undef PG8_STAGE
#undef PG8_LDA
#undef PG8_LDB
#undef PG8_MMA
#undef PG8_WAIT_V
#undef PG8_WAIT_L
#undef PG8_BAR
#undef PG8_SCHED
}
}


#ifndef MK_MULTI
#define MK_MULTI 0
#endif
#ifndef MK_DIAG
#define MK_DIAG 0
#endif
#ifndef YPERT
#define YPERT 1.0f
#define SPERT 1.0f
#define VPERT 1.0f
#define KPERT 1.0f
#endif
#ifndef MK_DET
#define MK_DET 0
#define DET_PH 17
#define DET_LO MiB
#define DET_HI WS_END
#define DET_NO_OUT 0
#endif
#ifndef MK_BAR
#define MK_BAR 1
#endif

typedef unsigned short bf16;
typedef short bf16x8 __attribute__((ext_vector_type(8)));
typedef float f32x2 __attribute__((ext_vector_type(2)));
typedef float f32x4 __attribute__((ext_vector_type(4)));
typedef float f32x16 __attribute__((ext_vector_type(16)));
typedef unsigned u32x4 __attribute__((ext_vector_type(4)));
typedef unsigned u32x2 __attribute__((ext_vector_type(2)));

constexpr int TR = 12288, TP = 8192, DM = 2048, DFF = 8192, NTHR = 512, NWAVE = 8;
constexpr float LN_EPS = 1e-5f, ALPHA = 1.41421356237f;
constexpr float QSCALE = 0.125f * 1.4426950408889634f;
constexpr size_t OUT_Y = 0, OUT_SRE = 25165824, OUT_SIM = 25427968, OUT_CK = 25690112, OUT_CV = 42467328;
constexpr size_t MiB = 1u << 20;
constexpr size_t WS_MOD = 0, WS_ROPE = 512 * 1024;
constexpr size_t WS_WIN = 2 * MiB, WS_WGLU = 14 * MiB, WS_WOAB = 16 * MiB, WS_WQKV = 24 * MiB, WS_WOC = 48 * MiB, WS_WF1 = 56 * MiB, WS_WF2 = 120 * MiB;
constexpr size_t WS_H = 184 * MiB, WS_F = 232 * MiB, WS_R = 280 * MiB;
constexpr size_t WS_A2 = WS_R;
constexpr size_t WS_UG = WS_R, WS_US = WS_R + 24 * MiB, WS_YF = WS_R + 48 * MiB, WS_YR = WS_R + 96 * MiB, WS_YS = WS_R + 144 * MiB, WS_CAT = WS_R + 168 * MiB;
constexpr size_t WS_QB = WS_R, WS_KP = WS_R + 48 * MiB, WS_VTP = WS_R + 80 * MiB, WS_KS = WS_R + 112 * MiB, WS_VTS = WS_R + 132 * MiB, WS_OA = WS_R + 152 * MiB;
constexpr size_t WS_F2 = WS_R + 216 * MiB;
constexpr size_t WS_END = WS_R + 264 * MiB;
constexpr int LDS_BYTES = 147456;

__device__ __forceinline__ unsigned pk(float lo, float hi) { return pg8::cvt_pk_bf16(lo, hi); }
__device__ __forceinline__ float bflo(unsigned u) { return __uint_as_float(u << 16); }
__device__ __forceinline__ float bfhi(unsigned u) { return __uint_as_float(u & 0xffff0000u); }
__device__ __forceinline__ float sigm(float x) { return __builtin_amdgcn_rcpf(1.f + __expf(-x)); }
__device__ __forceinline__ float wave_sum(float v) {
#pragma unroll
    for (int o = 1; o < 64; o <<= 1) v += __shfl_xor(v, o);
    return v;
}
__device__ __forceinline__ int crow(int r, int hi) { return (r & 3) + 8 * (r >> 2) + 4 * hi; }
#define LDS_FENCE() asm volatile("s_waitcnt lgkmcnt(0)" ::: "memory")
#define VM_DRAIN() asm volatile("s_waitcnt vmcnt(0)" ::: "memory")

namespace pg8 {
template <int RELU2> struct EpiPlain {
    static constexpr bool PERM = true, AFTER_DRAIN = false;
    bf16_t* O; int ldc;
    __device__ __forceinline__ void operator()(const f32x4 (&acc)[2][2][4][2], const Unit& u, int wr, int wc, int fr, int fq) const {
        const int row0 = u.pm * BM + wr * 64 + fr, col0 = u.pn * BM + wc * 32 + 8 * fq;
#pragma unroll
        for (int ai = 0; ai < 2; ++ai)
#pragma unroll
            for (int m = 0; m < 4; ++m) { bf16_t* rowp = O + (size_t)(row0 + ai * HALF + m * 16) * ldc + col0;
#pragma unroll
                for (int bj = 0; bj < 2; ++bj) { f32x4 v0 = acc[ai][bj][m][0], v1 = acc[ai][bj][m][1];
                    if (RELU2) {
#pragma unroll
                        for (int j = 0; j < 4; ++j) { float a = fmaxf(v0[j], 0.f), b = fmaxf(v1[j], 0.f); v0[j] = a * a; v1[j] = b * b; } }
                    u32x4 w; w.x = cvt_pk_bf16(v0[0], v0[1]); w.y = cvt_pk_bf16(v0[2], v0[3]); w.z = cvt_pk_bf16(v1[0], v1[1]); w.w = cvt_pk_bf16(v1[2], v1[3]);
                    *(u32x4*)(rowp + bj * HALF) = w; } }
    }
};
struct EpiSplit {
    static constexpr bool PERM = true, AFTER_DRAIN = false;
    bf16_t* O0; bf16_t* O1;
    __device__ __forceinline__ void operator()(const f32x4 (&acc)[2][2][4][2], const Unit& u, int wr, int wc, int fr, int fq) const {
        const int row0 = u.pm * BM + wr * 64 + fr, col0 = (u.pn & 7) * BM + wc * 32 + 8 * fq; bf16_t* O = (u.pn >> 3) ? O1 : O0;
#pragma unroll
        for (int ai = 0; ai < 2; ++ai)
#pragma unroll
            for (int m = 0; m < 4; ++m) { bf16_t* rowp = O + (size_t)(row0 + ai * HALF + m * 16) * 2048 + col0;
#pragma unroll
                for (int bj = 0; bj < 2; ++bj) { const f32x4 v0 = acc[ai][bj][m][0], v1 = acc[ai][bj][m][1];
                    u32x4 w; w.x = cvt_pk_bf16(v0[0], v0[1]); w.y = cvt_pk_bf16(v0[2], v0[3]); w.z = cvt_pk_bf16(v1[0], v1[1]); w.w = cvt_pk_bf16(v1[2], v1[3]);
                    *(u32x4*)(rowp + bj * HALF) = w; } }
    }
};
struct EpiIn {
    static constexpr bool PERM = true, AFTER_DRAIN = false;
    bf16_t* UG; bf16_t* US;
    __device__ __forceinline__ void operator()(const f32x4 (&acc)[2][2][4][2], const Unit& u, int wr, int wc, int fr, int fq) const {
        const int row0 = u.pm * BM + wr * 64 + fr;
        if (u.pn < 8) {
            const int col0 = u.pn * 128 + wc * 32 + 8 * fq;
#pragma unroll
            for (int ai = 0; ai < 2; ++ai)
#pragma unroll
                for (int m = 0; m < 4; ++m) { f32x4 v0 = acc[ai][0][m][0], v1 = acc[ai][0][m][1], g0 = acc[ai][1][m][0], g1 = acc[ai][1][m][1];
#pragma unroll
                    for (int j = 0; j < 4; ++j) { v0[j] *= sigm(g0[j]); v1[j] *= sigm(g1[j]); }
                    u32x4 w; w.x = cvt_pk_bf16(v0[0], v0[1]); w.y = cvt_pk_bf16(v0[2], v0[3]); w.z = cvt_pk_bf16(v1[0], v1[1]); w.w = cvt_pk_bf16(v1[2], v1[3]);
                    *(u32x4*)(UG + (size_t)(row0 + ai * HALF + m * 16) * 1024 + col0) = w; }
        } else {
            const int col0 = (u.pn - 8) * 256 + wc * 32 + 8 * fq;
#pragma unroll
            for (int ai = 0; ai < 2; ++ai)
#pragma unroll
                for (int m = 0; m < 4; ++m)
#pragma unroll
                    for (int bj = 0; bj < 2; ++bj) { f32x4 v0 = acc[ai][bj][m][0], v1 = acc[ai][bj][m][1];
                        u32x4 w; w.x = cvt_pk_bf16(v0[0], v0[1]); w.y = cvt_pk_bf16(v0[2], v0[3]); w.z = cvt_pk_bf16(v1[0], v1[1]); w.w = cvt_pk_bf16(v1[2], v1[3]);
                        *(u32x4*)(US + (size_t)(row0 + ai * HALF + m * 16) * 1024 + col0 + bj * HALF) = w; }
        }
    }
};
struct EpiGlu {
    static constexpr bool PERM = true, AFTER_DRAIN = false;
    const bf16_t* YS; bf16_t* CAT;
    __device__ __forceinline__ void operator()(const f32x4 (&acc)[2][2][4][2], const Unit& u, int wr, int wc, int fr, int fq) const {
        const int row0 = u.pm * BM + wr * 64 + fr, col0 = u.pn * BM + wc * 32 + 8 * fq;
#pragma unroll
        for (int ai = 0; ai < 2; ++ai) { u32x4 yv[4][2];
#pragma unroll
            for (int m = 0; m < 4; ++m)
#pragma unroll
                for (int bj = 0; bj < 2; ++bj) yv[m][bj] = *(const u32x4*)(YS + (size_t)(row0 + ai * HALF + m * 16) * 1024 + col0 + bj * HALF);
            asm volatile("s_waitcnt vmcnt(0)" ::: "memory");
#pragma unroll
            for (int m = 0; m < 4; ++m) { const size_t row = (size_t)(row0 + ai * HALF + m * 16);
#pragma unroll
                for (int bj = 0; bj < 2; ++bj) { const f32x4 v0 = acc[ai][bj][m][0], v1 = acc[ai][bj][m][1]; const u32x4 y = yv[m][bj];
                    u32x4 w;
                    w.x = cvt_pk_bf16(bflo(y.x) * sigm(v0[0]), bfhi(y.x) * sigm(v0[1])); w.y = cvt_pk_bf16(bflo(y.y) * sigm(v0[2]), bfhi(y.y) * sigm(v0[3]));
                    w.z = cvt_pk_bf16(bflo(y.z) * sigm(v1[0]), bfhi(y.z) * sigm(v1[1])); w.w = cvt_pk_bf16(bflo(y.w) * sigm(v1[2]), bfhi(y.w) * sigm(v1[3]));
                    *(u32x4*)(CAT + row * 2048 + 1024 + col0 + bj * HALF) = w; } } }
    }
};
struct EpiQkv {
    static constexpr bool PERM = true, AFTER_DRAIN = false;
    bf16_t *QB, *KP, *VTP, *KS, *VTS; float *outK, *outV; const f32x2* rope;
    __device__ __forceinline__ void operator()(const f32x4 (&acc)[2][2][4][2], const Unit& u, int wr, int wc, int fr, int fq) const {
        const bool sample = u.pm >= 32; const int row0 = u.pm * BM + wr * 64 + fr;
        if (u.pn < 16) {
            const bool isq = u.pn < 8; const int cbase = (u.pn & 7) * 256 + wc * 32 + 8 * fq;
#pragma unroll
            for (int ai = 0; ai < 2; ++ai)
#pragma unroll
                for (int m = 0; m < 4; ++m) { const int row = row0 + ai * HALF + m * 16; int bb, s;
                    if (sample) { const int rs = row - 8192; bb = rs >> 11; s = rs & 2047; } else { bb = row >> 8; s = row & 255; }
                    f32x2 csv[8];
                    if (sample) { const int pos = (wc & 1) ? (s & 63) : (s >> 6); const f32x2* tb = rope + pos * 16 + 8 * (fq & 1);
#pragma unroll
                        for (int j = 0; j < 8; ++j) csv[j] = tb[j];
                        asm volatile("s_waitcnt vmcnt(0)" ::: "memory"); }
#pragma unroll
                    for (int bj = 0; bj < 2; ++bj) { const int col = cbase + bj * HALF; const int mm = col >> 10, hh = (col >> 6) & 15, d = col & 63;
                        float v[8];
#pragma unroll
                        for (int j = 0; j < 4; ++j) { v[j] = acc[ai][bj][m][0][j]; v[4 + j] = acc[ai][bj][m][1][j]; }
                        if (sample) {
#pragma unroll
                            for (int j = 0; j < 8; ++j) { const f32x2 cs = csv[j]; const float pr = __shfl_xor(v[j], 32); v[j] = v[j] * cs.x + pr * (fq < 2 ? -cs.y : cs.y); } }
                        if (isq) {
                            u32x4 w; w.x = cvt_pk_bf16(v[0] * QSCALE, v[1] * QSCALE); w.y = cvt_pk_bf16(v[2] * QSCALE, v[3] * QSCALE); w.z = cvt_pk_bf16(v[4] * QSCALE, v[5] * QSCALE); w.w = cvt_pk_bf16(v[6] * QSCALE, v[7] * QSCALE);
                            *(u32x4*)(QB + (size_t)row * 2048 + col) = w;
                        } else {
                            u32x4 w; w.x = cvt_pk_bf16(v[0], v[1]); w.y = cvt_pk_bf16(v[2], v[3]); w.z = cvt_pk_bf16(v[4], v[5]); w.w = cvt_pk_bf16(v[6], v[7]);
                            if (sample) { *(u32x4*)(KS + ((size_t)((bb * 2 + mm) * 16 + hh) * 2560 + s) * 64 + d) = w; }
                            else { const size_t o = ((size_t)((bb * 2 + mm) * 16 + hh) * 256 + s) * 64 + d; *(u32x4*)(KP + o) = w;
                                *(f32x4*)(outK + o) = (f32x4){v[0], v[1], v[2], v[3]} * KPERT; *(f32x4*)(outK + o + 4) = (f32x4){v[4], v[5], v[6], v[7]} * KPERT; }
                        } } }
        } else {
            const int cbase = (u.pn - 16) * 256 + wc * 32 + 8 * fq;
#pragma unroll
            for (int ai = 0; ai < 2; ++ai)
#pragma unroll
                for (int m = 0; m < 4; ++m) { const int row = row0 + ai * HALF + m * 16; int bb, s;
                    if (sample) { const int rs = row - 8192; bb = rs >> 11; s = rs & 2047; } else { bb = row >> 8; s = row & 255; }
#pragma unroll
                    for (int bj = 0; bj < 2; ++bj) { const int col = cbase + bj * HALF; const int hh = col >> 7, dv = col & 127;
                        float v[8];
#pragma unroll
                        for (int j = 0; j < 4; ++j) { v[j] = acc[ai][bj][m][0][j]; v[4 + j] = acc[ai][bj][m][1][j]; }
                        if (sample) { bf16_t* vt = VTS + ((size_t)(bb * 16 + hh) * 128 + dv) * 2560 + s;
#pragma unroll
                            for (int j = 0; j < 8; ++j) vt[(size_t)j * 2560] = (bf16_t)cvt_pk_bf16(v[j], 0.f);
                        } else { bf16_t* vt = VTP + ((size_t)(bb * 16 + hh) * 128 + dv) * 256 + s;
#pragma unroll
                            for (int j = 0; j < 8; ++j) vt[(size_t)j * 256] = (bf16_t)cvt_pk_bf16(v[j], 0.f);
                            const size_t o = ((size_t)(bb * 16 + hh) * 256 + s) * 128 + dv;
                            *(f32x4*)(outV + o) = (f32x4){v[0], v[1], v[2], v[3]} * VPERT; *(f32x4*)(outV + o + 4) = (f32x4){v[4], v[5], v[6], v[7]} * VPERT; }
                    } }
        }
    }
};
}

struct Args { const float* in[36]; float* out; unsigned char* ws; int ph_lo, ph_hi; };
enum { I_XP = 0, I_XS, I_SRE, I_SIM, I_CK, I_CV, I_C, I_CCTX, I_WMOD, I_BMOD, I_LNG, I_LNB, I_WIN, I_WDW, I_BDW, I_CLNG, I_CLNB, I_LRE, I_LIM, I_LDT, I_BRE, I_BIM, I_CRE, I_CIM,
       I_S5D, I_WGLU, I_WOAB, I_WQKV, I_LQ1, I_LK1, I_LQ2, I_LK2, I_SUBG, I_WOC, I_WF1, I_WF2 };

__device__ __forceinline__ void transpose_item(const float* src, int N, int k0, int n0, bf16* dst, size_t dp, int drow0, int dcol0, float* scr, int lane, const float* kscale = nullptr, float kmul = 1.f) {
#pragma unroll 8
    for (int i = 0; i < 32; ++i) { const int kk = 2 * i + (lane >> 5); float v = __builtin_nontemporal_load(src + (size_t)(k0 + kk) * N + n0 + (lane & 31)); if (kscale) v *= kscale[(k0 + kk) & 127] * kmul; scr[kk * 33 + (lane & 31)] = v; }
    VM_DRAIN(); LDS_FENCE();
    const int c = lane & 7;
#pragma unroll
    for (int j = 0; j < 4; ++j) { const int n = (lane >> 3) + 8 * j; const float* s = scr + (8 * c) * 33 + n;
        u32x4 o; o.x = pk(s[0 * 33], s[1 * 33]); o.y = pk(s[2 * 33], s[3 * 33]); o.z = pk(s[4 * 33], s[5 * 33]); o.w = pk(s[6 * 33], s[7 * 33]);
        *(u32x4*)(dst + (size_t)(drow0 + n) * dp + dcol0 + 8 * c) = o; }
    LDS_FENCE();
}
__device__ __forceinline__ void wt_item(const float* W, int K, int N, bf16* WT, bool glu, int item, float* scr, int lane, const float* kscale = nullptr, float kmul = 1.f) {
    const int nblk = N / 32, kb = item / nblk, nb = item % nblk, k0 = 64 * kb, n0 = 32 * nb;
    int d0 = n0;
    if (glu) { if (n0 < 1024) d0 = (n0 >> 7) * 256 + (n0 & 127); else if (n0 < 2048) { const int n1 = n0 - 1024; d0 = (n1 >> 7) * 256 + 128 + (n1 & 127); } }
    transpose_item(W, N, k0, n0, WT, (size_t)K, d0, k0, scr, lane, kscale, kmul);
}
__device__ __forceinline__ void p0_prep(const Args& a, unsigned char* lds, int bid, int G) {
    const int tid = threadIdx.x, lane = tid & 63, wave = tid >> 6;
    float* silu = (float*)lds;
    float* red = (float*)(lds + 98304);
    float* scr = (float*)(lds + 24576 + wave * 8704);
    float* MOD = (float*)(a.ws + WS_MOD);
    if (bid == 0) { f32x2* tab = (f32x2*)(a.ws + WS_ROPE);
        for (int e = tid; e < 1024; e += NTHR) { const int pos = e >> 4, i = e & 15; const float fr = powf(10000.f, -(float)i / 16.f); float sn, cs; sincosf((float)pos * fr, &sn, &cs); tab[e] = (f32x2){cs, sn}; } }
    bool have_silu = false;
    for (int unit = bid; unit < 384; unit += G) {
        if (!have_silu) { for (int e = tid; e < 3 * 2048; e += NTHR) { const int g = e >> 11, k = e & 2047; const float x = g == 0 ? a.in[I_CCTX][k] : a.in[I_C][(g - 1) * 2048 + k]; silu[e] = x * sigm(x); } have_silu = true; __syncthreads(); }
        const int l = unit / 192, cb = unit % 192, q = lane >> 4, li = lane & 15, ks = wave * 4 + q;
        const float* W = a.in[I_WMOD] + (size_t)l * 2048 * 12288 + cb * 64 + li * 4;
        f32x4 a0 = {0.f, 0.f, 0.f, 0.f}, a1 = a0, a2 = a0;
#pragma unroll 8
        for (int i = 0; i < 64; ++i) { const int k = ks + 32 * i; const f32x4 w = __builtin_nontemporal_load((const f32x4*)(W + (size_t)k * 12288));
            a0 += w * silu[k]; a1 += w * silu[2048 + k]; a2 += w * silu[4096 + k]; }
        *(f32x4*)(red + ks * 192 + li * 4) = a0; *(f32x4*)(red + ks * 192 + 64 + li * 4) = a1; *(f32x4*)(red + ks * 192 + 128 + li * 4) = a2;
        __syncthreads();
        if (tid < 192) { float s = 0.f;
#pragma unroll 8
            for (int k = 0; k < 32; ++k) s += red[k * 192 + tid];
            const int grp = tid >> 6, col = cb * 64 + (tid & 63); MOD[(size_t)(l * 3 + grp) * 12288 + col] = s + a.in[I_BMOD][l * 12288 + col]; }
        __syncthreads();
    }
    const int gw = bid * NWAVE + wave, NGW = G * NWAVE;
    constexpr int I0 = 32 * 96, I1 = 16 * 32, I2 = 32 * 64, I3 = 32 * 192, I4 = 32 * 64, I5 = 32 * 256, I6 = 128 * 64;
    constexpr int NIT = I0 + I1 + I2 + I3 + I4 + 2 * I5 + 2 * I6;
#ifndef P0_NO_WT
#ifndef WT_LIMIT
#define WT_LIMIT NIT
#endif
#ifndef WT_START
#define WT_START 0
#endif
    for (int it = WT_START + gw; it < WT_LIMIT; it += NGW) { int r = it;
        if (r < I0) { wt_item(a.in[I_WIN], 2048, 3072, (bf16*)(a.ws + WS_WIN), true, r, scr, lane); continue; } r -= I0;
        if (r < I1) { wt_item(a.in[I_WGLU], 1024, 1024, (bf16*)(a.ws + WS_WGLU), false, r, scr, lane); continue; } r -= I1;
        if (r < I2) { wt_item(a.in[I_WOAB], 2048, 2048, (bf16*)(a.ws + WS_WOAB), false, r, scr, lane); continue; } r -= I2;
        if (r < I3) { wt_item(a.in[I_WQKV], 2048, 6144, (bf16*)(a.ws + WS_WQKV), false, r, scr, lane); continue; } r -= I3;
        if (r < I4) { wt_item(a.in[I_WOC], 2048, 2048, (bf16*)(a.ws + WS_WOC), false, r, scr, lane, a.in[I_SUBG], 1.f - (0.8f - 0.6f * expf(-0.3f))); continue; } r -= I4;
        if (r < I5) { wt_item(a.in[I_WF1], 2048, 8192, (bf16*)(a.ws + WS_WF1), false, r, scr, lane); continue; } r -= I5;
        if (r < I5) { wt_item(a.in[I_WF1] + (size_t)2048 * 8192, 2048, 8192, (bf16*)(a.ws + WS_WF1 + (size_t)2048 * 8192 * 2), false, r, scr, lane); continue; } r -= I5;
        if (r < I6) { wt_item(a.in[I_WF2], 8192, 2048, (bf16*)(a.ws + WS_WF2), false, r, scr, lane); continue; } r -= I6;
        if (r < I6) { wt_item(a.in[I_WF2] + (size_t)2048 * 8192, 8192, 2048, (bf16*)(a.ws + WS_WF2 + (size_t)2048 * 8192 * 2), false, r, scr, lane); }
    }
#endif
}

__device__ __forceinline__ int row_grp(int row) { return row < TP ? 0 : 1 + ((row - TP) >> 11); }
__device__ __forceinline__ void p_mod_in(const Args& a, int bid, int G) {
    const int lane = threadIdx.x & 63, wave = threadIdx.x >> 6; const int gw = bid * NWAVE + wave, NGW = G * NWAVE;
    const float* MOD = (const float*)(a.ws + WS_MOD); bf16* H = (bf16*)(a.ws + WS_H);
    for (int row = gw; row < TR; row += NGW) {
        const float* x = row < TP ? a.in[I_XP] + (size_t)row * DM : a.in[I_XS] + (size_t)(row - TP) * DM;
        const float* md = MOD + (size_t)row_grp(row) * 12288;
        f32x4 xv[8], shv[8], scv[8];
#pragma unroll
        for (int j = 0; j < 8; ++j) { const int c = j * 256 + lane * 4; xv[j] = *(const f32x4*)(x + c); shv[j] = *(const f32x4*)(md + c); scv[j] = *(const f32x4*)(md + 2048 + c); }
        VM_DRAIN();
#pragma unroll
        for (int j = 0; j < 8; ++j) { const int c = j * 256 + lane * 4; const f32x4 o = xv[j] * (scv[j] + 1.f) + shv[j]; u32x2 w; w.x = pk(o[0], o[1]); w.y = pk(o[2], o[3]); *(u32x2*)(H + (size_t)row * DM + c) = w; }
    }
}
__device__ __forceinline__ void p_ln(const Args& a, int bid, int G, bool xin_first, const float* gate_base  , const float* lng, const float* lnb,
                                     const float* nxt_base  ) {
    const int lane = threadIdx.x & 63, wave = threadIdx.x >> 6; const int gw = bid * NWAVE + wave, NGW = G * NWAVE;
    const bf16* F = (const bf16*)(a.ws + WS_F); const bf16* F2 = (const bf16*)(a.ws + WS_F2); bf16* H = (bf16*)(a.ws + WS_H); float* Y = a.out + OUT_Y;
    for (int row = gw; row < TR; row += NGW) {
        const float* x = xin_first ? (row < TP ? a.in[I_XP] + (size_t)row * DM : a.in[I_XS] + (size_t)(row - TP) * DM) : Y + (size_t)row * DM;
        const int grp = row_grp(row); const float* gt = gate_base + (size_t)grp * 12288;
        f32x4 z[8]; float s = 0.f;
#pragma unroll
        for (int j = 0; j < 8; ++j) { const int c = j * 256 + lane * 4; const f32x4 v = *(const f32x4*)(x + c), g = *(const f32x4*)(gt + c); const u32x2 f = *(const u32x2*)(F + (size_t)row * DM + c), f2 = *(const u32x2*)(F2 + (size_t)row * DM + c);
            f32x4 o; o[0] = ALPHA * v[0] + g[0] * (bflo(f.x) + bflo(f2.x)); o[1] = ALPHA * v[1] + g[1] * (bfhi(f.x) + bfhi(f2.x)); o[2] = ALPHA * v[2] + g[2] * (bflo(f.y) + bflo(f2.y)); o[3] = ALPHA * v[3] + g[3] * (bfhi(f.y) + bfhi(f2.y));
            z[j] = o; s += (o[0] + o[1]) + (o[2] + o[3]); }
        VM_DRAIN();
        const float mean = wave_sum(s) * (1.f / DM); float s2 = 0.f;
#pragma unroll
        for (int j = 0; j < 8; ++j) { z[j] = z[j] - mean; s2 += (z[j][0] * z[j][0] + z[j][1] * z[j][1]) + (z[j][2] * z[j][2] + z[j][3] * z[j][3]); }
        const float rstd = 1.f / sqrtf(wave_sum(s2) * (1.f / DM) + LN_EPS);
#pragma unroll
        for (int hh = 0; hh < 2; ++hh) {
            f32x4 gv[4], bv[4], shv[4], scv[4];
#pragma unroll
            for (int jj = 0; jj < 4; ++jj) { const int c = (hh * 4 + jj) * 256 + lane * 4; gv[jj] = *(const f32x4*)(lng + c); bv[jj] = *(const f32x4*)(lnb + c);
                if (nxt_base) { const float* nb = nxt_base + (size_t)grp * 12288; shv[jj] = *(const f32x4*)(nb + c); scv[jj] = *(const f32x4*)(nb + 2048 + c); } }
            VM_DRAIN();
#pragma unroll
            for (int jj = 0; jj < 4; ++jj) { const int j = hh * 4 + jj, c = j * 256 + lane * 4;
                f32x4 y = z[j] * rstd * gv[jj] + bv[jj]; if (!nxt_base) y = y * YPERT; *(f32x4*)(Y + (size_t)row * DM + c) = y;
                if (nxt_base) { const f32x4 o = y * (scv[jj] + 1.f) + shv[jj]; u32x2 w; w.x = pk(o[0], o[1]); w.y = pk(o[2], o[3]); *(u32x2*)(H + (size_t)row * DM + c) = w; } }
        }
    }
}

__device__ __forceinline__ float gelu_tanh(float x) { const float u = 0.7978845608028654f * (x + 0.044715f * x * x * x); const float e = __expf(2.f * u); const float t = 1.f - 2.f * __builtin_amdgcn_rcpf(e + 1.f); return 0.5f * x * (1.f + t); }
__device__ __forceinline__ void s5_item(const Args& a, unsigned char* wl, bool sample, int b, int g, int dir, int lane) {
    const int L = sample ? 2048 : 256, row0 = sample ? TP + b * 2048 : b * 256, fr = lane & 15, fq = lane >> 4;
    const bf16* US = (const bf16*)(a.ws + WS_US); float* Yo = (float*)(a.ws + (dir ? WS_YR : WS_YF));
    unsigned char* BU = wl; unsigned char* Hl = wl + 8448;
    const int pg = (dir * 64 + g) * 64;
    const float dt = expf(a.in[I_LDT][dir * 64 + g]);
    float lbr, lbi;
    { const float lre = a.in[I_LRE][pg + lane], lim = a.in[I_LIM][pg + lane]; const float mag = expf(lre * dt); float sn, cs; sincosf(lim * dt, &sn, &cs); lbr = mag * cs; lbi = mag * sn; }
    bf16x8 bbop[8];
#pragma unroll
    for (int t = 0; t < 8; ++t) { const int n = 8 * t + (fr >> 1), c = fr & 1;
        const float lre = a.in[I_LRE][pg + n], lim = a.in[I_LIM][pg + n]; const float mag = expf(lre * dt); float sn, cs; sincosf(lim * dt, &sn, &cs);
        const float br = mag * cs, bi = mag * sn, den = 1.f / (lre * lre + lim * lim);
        const float cr = ((br - 1.f) * lre + bi * lim) * den, ci = (bi * lre - (br - 1.f) * lim) * den;
        const float* pbr = a.in[I_BRE] + (size_t)(pg + n) * 16 + 8 * (fq & 1); const float* pbi = a.in[I_BIM] + (size_t)(pg + n) * 16 + 8 * (fq & 1);
        const f32x4 r0 = *(const f32x4*)pbr, r1 = *(const f32x4*)(pbr + 4), i0 = *(const f32x4*)pbi, i1 = *(const f32x4*)(pbi + 4);
        float v[8];
#pragma unroll
        for (int j = 0; j < 4; ++j) { v[j] = c == 0 ? cr * r0[j] - ci * i0[j] : cr * i0[j] + ci * r0[j]; v[4 + j] = c == 0 ? cr * r1[j] - ci * i1[j] : cr * i1[j] + ci * r1[j]; }
        unsigned w[4];
#pragma unroll
        for (int j = 0; j < 4; ++j) { const unsigned h2 = pk(v[2 * j], v[2 * j + 1]); const unsigned l2 = pk(v[2 * j] - bflo(h2), v[2 * j + 1] - bfhi(h2)); w[j] = fq < 2 ? h2 : l2; }
        bbop[t] = __builtin_bit_cast(bf16x8, (u32x4){w[0], w[1], w[2], w[3]}); }
    bf16x8 cmop[4];
#pragma unroll
    for (int s = 0; s < 4; ++s) { const int n0 = 16 * s + 4 * fq; const size_t o = (size_t)((dir * 64 + g) * 16 + fr) * 64 + n0;
        const f32x4 cr = *(const f32x4*)(a.in[I_CRE] + o), ci = *(const f32x4*)(a.in[I_CIM] + o);
        cmop[s] = __builtin_bit_cast(bf16x8, (u32x4){pk(cr[0], -ci[0]), pk(cr[1], -ci[1]), pk(cr[2], -ci[2]), pk(cr[3], -ci[3])}); }
    float hr = 0.f, hi_ = 0.f;
    if (sample) { const size_t o = (size_t)((b * 2 + dir) * 64 + g) * 64 + lane; hr = a.in[I_SRE][o]; hi_ = a.in[I_SIM][o]; }
    const int nch = L / 16;
#define MFMA_PAD4(a0, a1, a2, a3) asm volatile("s_nop 15\n\ts_nop 15" : "+v"(a0), "+v"(a1), "+v"(a2), "+v"(a3))
#define S5_ULOAD(C) (*(const u32x4*)(US + (size_t)(row0 + (dir ? L - 1 - 16 * (C) - fr : 16 * (C) + fr)) * 1024 + g * 16 + 8 * (fq & 1)))
#define S5_YSTORE(C) do { _Pragma("unroll") for (int i = 0; i < 4; ++i) { const int ti = 4 * fq + i; const int tk = dir ? L - 1 - 16 * (C) - ti : 16 * (C) + ti; Yo[(size_t)(row0 + tk) * 1024 + g * 16 + fr] = yprev[i]; } } while (0)
#define S5_CHUNK(C, UCUR, UNEXT) do { const int c = (C); \
        VM_DRAIN();                                     \
        if (c > 0) S5_YSTORE(c - 1);                    \
        if (c + 1 < nch) UNEXT = S5_ULOAD(c + 1); \
        const bf16x8 ua = __builtin_bit_cast(bf16x8, UCUR); f32x4 acc[8]; \
        _Pragma("unroll") for (int t = 0; t < 8; ++t) { acc[t] = (f32x4){0.f, 0.f, 0.f, 0.f}; acc[t] = __builtin_amdgcn_mfma_f32_16x16x32_bf16(ua, bbop[t], acc[t], 0, 0, 0); } \
        MFMA_PAD4(acc[0], acc[1], acc[2], acc[3]); MFMA_PAD4(acc[4], acc[5], acc[6], acc[7]); \
        _Pragma("unroll") for (int t = 0; t < 8; ++t) \
            _Pragma("unroll") for (int i = 0; i < 4; ++i) *(float*)(BU + (4 * fq + i) * 528 + (16 * t + fr) * 4) = acc[t][i]; \
        LDS_FENCE(); \
        f32x2 buv[16];                                  \
        _Pragma("unroll") for (int i = 0; i < 16; ++i) buv[i] = *(const f32x2*)(BU + i * 528 + lane * 8); \
        LDS_FENCE(); \
        _Pragma("unroll") for (int i = 0; i < 16; ++i) { \
            float t0, t1, nr, ni; \
            asm volatile("v_fma_f32 %0, -%5, %7, %8\n\tv_fma_f32 %1, %5, %6, %9\n\tv_fma_f32 %2, %4, %6, %0\n\tv_fma_f32 %3, %4, %7, %1" \
                         : "=&v"(t0), "=&v"(t1), "=&v"(nr), "=&v"(ni) : "v"(lbr), "v"(lbi), "v"(hr), "v"(hi_), "v"(buv[i].x), "v"(buv[i].y)); \
            hr = nr; hi_ = ni; \
            *(unsigned*)(Hl + i * 272 + lane * 4) = pk(hr, hi_); } \
        LDS_FENCE(); \
        f32x4 y = {0.f, 0.f, 0.f, 0.f}; \
        _Pragma("unroll") for (int s = 0; s < 4; ++s) { const bf16x8 ha = *(const bf16x8*)(Hl + fr * 272 + 64 * s + 16 * fq); y = __builtin_amdgcn_mfma_f32_16x16x32_bf16(ha, cmop[s], y, 0, 0, 0); } \
        asm volatile("s_nop 15\n\ts_nop 15" : "+v"(y)); \
        yprev = y; \
        LDS_FENCE(); } while (0)
    f32x4 yprev = {0.f, 0.f, 0.f, 0.f};
    u32x4 uA = S5_ULOAD(0), uB = uA;
    for (int c2 = 0; c2 < nch; c2 += 2) { S5_CHUNK(c2, uA, uB); S5_CHUNK(c2 + 1, uB, uA); }
    S5_YSTORE(nch - 1);
#undef S5_YSTORE
#undef S5_CHUNK
#undef S5_ULOAD
    if (!sample) { const size_t o = (size_t)((b * 2 + dir) * 64 + g) * 64 + lane; a.out[OUT_SRE + o] = hr * SPERT; a.out[OUT_SIM + o] = hi_ * SPERT; }
}
__device__ __forceinline__ void s5_block(const Args& a, unsigned char* lds, bool sample, int task) {
    const int tid = threadIdx.x, lane = tid & 63, wave = tid >> 6;
    const int pi = task * 4 + (wave >> 1), b = pi >> 6, g = pi & 63;
    s5_item(a, lds + wave * 12800, sample, b, g, wave & 1, lane);
    __threadfence(); __syncthreads();
    const int L = sample ? 2048 : 256; const float* YF = (const float*)(a.ws + WS_YF); const float* YR = (const float*)(a.ws + WS_YR); const bf16* US = (const bf16*)(a.ws + WS_US); bf16* YS = (bf16*)(a.ws + WS_YS);
    for (int e0 = tid; e0 < 4 * L * 4; e0 += 4 * NTHR) {
        f32x4 f[4], r[4], dsk[4]; u32x2 uu[4]; size_t oo[4];
#pragma unroll
        for (int k = 0; k < 4; ++k) { const int e = e0 + k * NTHR; const int q = e & 3, t = (e >> 2) % L, pp = (e >> 2) / L; const int pj = task * 4 + pp, bb = pj >> 6, gg = pj & 63;
            const size_t o = (size_t)((sample ? TP + bb * 2048 : bb * 256) + t) * 1024 + gg * 16 + q * 4; oo[k] = o;
            f[k] = *(const f32x4*)(YF + o); r[k] = *(const f32x4*)(YR + o); dsk[k] = *(const f32x4*)(a.in[I_S5D] + gg * 16 + q * 4); uu[k] = *(const u32x2*)(US + o); }
        VM_DRAIN();
#pragma unroll
        for (int k = 0; k < 4; ++k) {
            const float v0 = gelu_tanh(f[k][0] + r[k][0] + dsk[k][0] * bflo(uu[k].x)), v1 = gelu_tanh(f[k][1] + r[k][1] + dsk[k][1] * bfhi(uu[k].x)), v2 = gelu_tanh(f[k][2] + r[k][2] + dsk[k][2] * bflo(uu[k].y)), v3 = gelu_tanh(f[k][3] + r[k][3] + dsk[k][3] * bfhi(uu[k].y));
            u32x2 w; w.x = pk(v0, v1); w.y = pk(v2, v3); *(u32x2*)(YS + oo[k]) = w; }
    }
    __syncthreads();
}
__device__ __forceinline__ void conv_tile(const Args& a, unsigned char* lds, int tile) {
    const int tid = threadIdx.x, lane = tid & 63; const int r0 = tile * 32; int s0, s1;
    if (r0 < TP) { s0 = r0 & ~255; s1 = s0 + 256; } else { s0 = TP + ((r0 - TP) & ~2047); s1 = s0 + 2048; }
    const bf16* UG = (const bf16*)(a.ws + WS_UG); bf16* CAT = (bf16*)(a.ws + WS_CAT); const int c = tid * 2;
    float* part = (float*)lds;
    float* stat = (float*)(lds + 32 * 520 * 4);
    unsigned* lin = (unsigned*)lds;
#pragma unroll 8
    for (int r = 0; r < 62; ++r) { const int row = r0 - 15 + r; unsigned u = 0u; if (row >= s0 && row < s1) u = *(const unsigned*)(UG + (size_t)row * 1024 + c); lin[r * 512 + tid] = u; }
    f32x2 w[31];
#pragma unroll
    for (int k = 0; k < 31; ++k) w[k] = *(const f32x2*)(a.in[I_WDW] + k * 1024 + c);
    const f32x2 bias = *(const f32x2*)(a.in[I_BDW] + c);
    f32x2 acc[32];
#pragma unroll
    for (int t = 0; t < 32; ++t) acc[t] = bias;
    LDS_FENCE();
    const unsigned* lin0 = lin + tid; const unsigned* lin1 = lin + 31 * 512 + tid;
    { const unsigned u = lin0[0 * 512]; f32x2 v; v.x = bflo(u); v.y = bfhi(u); acc[0] += w[0] * v; }
    { const unsigned u = lin0[1 * 512]; f32x2 v; v.x = bflo(u); v.y = bfhi(u); acc[1] += w[0] * v; acc[0] += w[1] * v; }
    asm volatile("" ::: "memory");
    { const unsigned u = lin0[2 * 512]; f32x2 v; v.x = bflo(u); v.y = bfhi(u); acc[2] += w[0] * v; acc[1] += w[1] * v; acc[0] += w[2] * v; }
    { const unsigned u = lin0[3 * 512]; f32x2 v; v.x = bflo(u); v.y = bfhi(u); acc[3] += w[0] * v; acc[2] += w[1] * v; acc[1] += w[2] * v; acc[0] += w[3] * v; }
    asm volatile("" ::: "memory");
    { const unsigned u = lin0[4 * 512]; f32x2 v; v.x = bflo(u); v.y = bfhi(u); acc[4] += w[0] * v; acc[3] += w[1] * v; acc[2] += w[2] * v; acc[1] += w[3] * v; acc[0] += w[4] * v; }
    { const unsigned u = lin0[5 * 512]; f32x2 v; v.x = bflo(u); v.y = bfhi(u); acc[5] += w[0] * v; acc[4] += w[1] * v; acc[3] += w[2] * v; acc[2] += w[3] * v; acc[1] += w[4] * v; acc[0] += w[5] * v; }
    asm volatile("" ::: "memory");
    { const unsigned u = lin0[6 * 512]; f32x2 v; v.x = bflo(u); v.y = bfhi(u); acc[6] += w[0] * v; acc[5] += w[1] * v; acc[4] += w[2] * v; acc[3] += w[3] * v; acc[2] += w[4] * v; acc[1] += w[5] * v; acc[0] += w[6] * v; }
    { const unsigned u = lin0[7 * 512]; f32x2 v; v.x = bflo(u); v.y = bfhi(u); acc[7] += w[0] * v; acc[6] += w[1] * v; acc[5] += w[2] * v; acc[4] += w[3] * v; acc[3] += w[4] * v; acc[2] += w[5] * v; acc[1] += w[6] * v; acc[0] += w[7] * v; }
    asm volatile("" ::: "memory");
    { const unsigned u = lin0[8 * 512]; f32x2 v; v.x = bflo(u); v.y = bfhi(u); acc[8] += w[0] * v; acc[7] += w[1] * v; acc[6] += w[2] * v; acc[5] += w[3] * v; acc[4] += w[4] * v; acc[3] += w[5] * v; acc[2] += w[6] * v; acc[1] += w[7] * v; acc[0] += w[8] * v; }
    { const unsigned u = lin0[9 * 512]; f32x2 v; v.x = bflo(u); v.y = bfhi(u); acc[9] += w[0] * v; acc[8] += w[1] * v; acc[7] += w[2] * v; acc[6] += w[3] * v; acc[5] += w[4] * v; acc[4] += w[5] * v; acc[3] += w[6] * v; acc[2] += w[7] * v; acc[1] += w[8] * v; acc[0] += w[9] * v; }
    asm volatile("" ::: "memory");
    { const unsigned u = lin0[10 * 512]; f32x2 v; v.x = bflo(u); v.y = bfhi(u); acc[10] += w[0] * v; acc[9] += w[1] * v; acc[8] += w[2] * v; acc[7] += w[3] * v; acc[6] += w[4] * v; acc[5] += w[5] * v; acc[4] += w[6] * v; acc[3] += w[7] * v; acc[2] += w[8] * v; acc[1] += w[9] * v; acc[0] += w[10] * v; }
    { const unsigned u = lin0[11 * 512]; f32x2 v; v.x = bflo(u); v.y = bfhi(u); acc[11] += w[0] * v; acc[10] += w[1] * v; acc[9] += w[2] * v; acc[8] += w[3] * v; acc[7] += w[4] * v; acc[6] += w[5] * v; acc[5] += w[6] * v; acc[4] += w[7] * v; acc[3] += w[8] * v; acc[2] += w[9] * v; acc[1] += w[10] * v; acc[0] += w[11] * v; }
    asm volatile("" ::: "memory");
    { const unsigned u = lin0[12 * 512]; f32x2 v; v.x = bflo(u); v.y = bfhi(u); acc[12] += w[0] * v; acc[11] += w[1] * v; acc[10] += w[2] * v; acc[9] += w[3] * v; acc[8] += w[4] * v; acc[7] += w[5] * v; acc[6] += w[6] * v; acc[5] += w[7] * v; acc[4] += w[8] * v; acc[3] += w[9] * v; acc[2] += w[10] * v; acc[1] += w[11] * v; acc[0] += w[12] * v; }
    { const unsigned u = lin0[13 * 512]; f32x2 v; v.x = bflo(u); v.y = bfhi(u); acc[13] += w[0] * v; acc[12] += w[1] * v; acc[11] += w[2] * v; acc[10] += w[3] * v; acc[9] += w[4] * v; acc[8] += w[5] * v; acc[7] += w[6] * v; acc[6] += w[7] * v; acc[5] += w[8] * v; acc[4] += w[9] * v; acc[3] += w[10] * v; acc[2] += w[11] * v; acc[1] += w[12] * v; acc[0] += w[13] * v; }
    asm volatile("" ::: "memory");
    { const unsigned u = lin0[14 * 512]; f32x2 v; v.x = bflo(u); v.y = bfhi(u); acc[14] += w[0] * v; acc[13] += w[1] * v; acc[12] += w[2] * v; acc[11] += w[3] * v; acc[10] += w[4] * v; acc[9] += w[5] * v; acc[8] += w[6] * v; acc[7] += w[7] * v; acc[6] += w[8] * v; acc[5] += w[9] * v; acc[4] += w[10] * v; acc[3] += w[11] * v; acc[2] += w[12] * v; acc[1] += w[13] * v; acc[0] += w[14] * v; }
    { const unsigned u = lin0[15 * 512]; f32x2 v; v.x = bflo(u); v.y = bfhi(u); acc[15] += w[0] * v; acc[14] += w[1] * v; acc[13] += w[2] * v; acc[12] += w[3] * v; acc[11] += w[4] * v; acc[10] += w[5] * v; acc[9] += w[6] * v; acc[8] += w[7] * v; acc[7] += w[8] * v; acc[6] += w[9] * v; acc[5] += w[10] * v; acc[4] += w[11] * v; acc[3] += w[12] * v; acc[2] += w[13] * v; acc[1] += w[14] * v; acc[0] += w[15] * v; }
    asm volatile("" ::: "memory");
    { const unsigned u = lin0[16 * 512]; f32x2 v; v.x = bflo(u); v.y = bfhi(u); acc[16] += w[0] * v; acc[15] += w[1] * v; acc[14] += w[2] * v; acc[13] += w[3] * v; acc[12] += w[4] * v; acc[11] += w[5] * v; acc[10] += w[6] * v; acc[9] += w[7] * v; acc[8] += w[8] * v; acc[7] += w[9] * v; acc[6] += w[10] * v; acc[5] += w[11] * v; acc[4] += w[12] * v; acc[3] += w[13] * v; acc[2] += w[14] * v; acc[1] += w[15] * v; acc[0] += w[16] * v; }
    { const unsigned u = lin0[17 * 512]; f32x2 v; v.x = bflo(u); v.y = bfhi(u); acc[17] += w[0] * v; acc[16] += w[1] * v; acc[15] += w[2] * v; acc[14] += w[3] * v; acc[13] += w[4] * v; acc[12] += w[5] * v; acc[11] += w[6] * v; acc[10] += w[7] * v; acc[9] += w[8] * v; acc[8] += w[9] * v; acc[7] += w[10] * v; acc[6] += w[11] * v; acc[5] += w[12] * v; acc[4] += w[13] * v; acc[3] += w[14] * v; acc[2] += w[15] * v; acc[1] += w[16] * v; acc[0] += w[17] * v; }
    asm volatile("" ::: "memory");
    { const unsigned u = lin0[18 * 512]; f32x2 v; v.x = bflo(u); v.y = bfhi(u); acc[18] += w[0] * v; acc[17] += w[1] * v; acc[16] += w[2] * v; acc[15] += w[3] * v; acc[14] += w[4] * v; acc[13] += w[5] * v; acc[12] += w[6] * v; acc[11] += w[7] * v; acc[10] += w[8] * v; acc[9] += w[9] * v; acc[8] += w[10] * v; acc[7] += w[11] * v; acc[6] += w[12] * v; acc[5] += w[13] * v; acc[4] += w[14] * v; acc[3] += w[15] * v; acc[2] += w[16] * v; acc[1] += w[17] * v; acc[0] += w[18] * v; }
    { const unsigned u = lin0[19 * 512]; f32x2 v; v.x = bflo(u); v.y = bfhi(u); acc[19] += w[0] * v; acc[18] += w[1] * v; acc[17] += w[2] * v; acc[16] += w[3] * v; acc[15] += w[4] * v; acc[14] += w[5] * v; acc[13] += w[6] * v; acc[12] += w[7] * v; acc[11] += w[8] * v; acc[10] += w[9] * v; acc[9] += w[10] * v; acc[8] += w[11] * v; acc[7] += w[12] * v; acc[6] += w[13] * v; acc[5] += w[14] * v; acc[4] += w[15] * v; acc[3] += w[16] * v; acc[2] += w[17] * v; acc[1] += w[18] * v; acc[0] += w[19] * v; }
    asm volatile("" ::: "memory");
    { const unsigned u = lin0[20 * 512]; f32x2 v; v.x = bflo(u); v.y = bfhi(u); acc[20] += w[0] * v; acc[19] += w[1] * v; acc[18] += w[2] * v; acc[17] += w[3] * v; acc[16] += w[4] * v; acc[15] += w[5] * v; acc[14] += w[6] * v; acc[13] += w[7] * v; acc[12] += w[8] * v; acc[11] += w[9] * v; acc[10] += w[10] * v; acc[9] += w[11] * v; acc[8] += w[12] * v; acc[7] += w[13] * v; acc[6] += w[14] * v; acc[5] += w[15] * v; acc[4] += w[16] * v; acc[3] += w[17] * v; acc[2] += w[18] * v; acc[1] += w[19] * v; acc[0] += w[20] * v; }
    { const unsigned u = lin0[21 * 512]; f32x2 v; v.x = bflo(u); v.y = bfhi(u); acc[21] += w[0] * v; acc[20] += w[1] * v; acc[19] += w[2] * v; acc[18] += w[3] * v; acc[17] += w[4] * v; acc[16] += w[5] * v; acc[15] += w[6] * v; acc[14] += w[7] * v; acc[13] += w[8] * v; acc[12] += w[9] * v; acc[11] += w[10] * v; acc[10] += w[11] * v; acc[9] += w[12] * v; acc[8] += w[13] * v; acc[7] += w[14] * v; acc[6] += w[15] * v; acc[5] += w[16] * v; acc[4] += w[17] * v; acc[3] += w[18] * v; acc[2] += w[19] * v; acc[1] += w[20] * v; acc[0] += w[21] * v; }
    asm volatile("" ::: "memory");
    { const unsigned u = lin0[22 * 512]; f32x2 v; v.x = bflo(u); v.y = bfhi(u); acc[22] += w[0] * v; acc[21] += w[1] * v; acc[20] += w[2] * v; acc[19] += w[3] * v; acc[18] += w[4] * v; acc[17] += w[5] * v; acc[16] += w[6] * v; acc[15] += w[7] * v; acc[14] += w[8] * v; acc[13] += w[9] * v; acc[12] += w[10] * v; acc[11] += w[11] * v; acc[10] += w[12] * v; acc[9] += w[13] * v; acc[8] += w[14] * v; acc[7] += w[15] * v; acc[6] += w[16] * v; acc[5] += w[17] * v; acc[4] += w[18] * v; acc[3] += w[19] * v; acc[2] += w[20] * v; acc[1] += w[21] * v; acc[0] += w[22] * v; }
    { const unsigned u = lin0[23 * 512]; f32x2 v; v.x = bflo(u); v.y = bfhi(u); acc[23] += w[0] * v; acc[22] += w[1] * v; acc[21] += w[2] * v; acc[20] += w[3] * v; acc[19] += w[4] * v; acc[18] += w[5] * v; acc[17] += w[6] * v; acc[16] += w[7] * v; acc[15] += w[8] * v; acc[14] += w[9] * v; acc[13] += w[10] * v; acc[12] += w[11] * v; acc[11] += w[12] * v; acc[10] += w[13] * v; acc[9] += w[14] * v; acc[8] += w[15] * v; acc[7] += w[16] * v; acc[6] += w[17] * v; acc[5] += w[18] * v; acc[4] += w[19] * v; acc[3] += w[20] * v; acc[2] += w[21] * v; acc[1] += w[22] * v; acc[0] += w[23] * v; }
    asm volatile("" ::: "memory");
    { const unsigned u = lin0[24 * 512]; f32x2 v; v.x = bflo(u); v.y = bfhi(u); acc[24] += w[0] * v; acc[23] += w[1] * v; acc[22] += w[2] * v; acc[21] += w[3] * v; acc[20] += w[4] * v; acc[19] += w[5] * v; acc[18] += w[6] * v; acc[17] += w[7] * v; acc[16] += w[8] * v; acc[15] += w[9] * v; acc[14] += w[10] * v; acc[13] += w[11] * v; acc[12] += w[12] * v; acc[11] += w[13] * v; acc[10] += w[14] * v; acc[9] += w[15] * v; acc[8] += w[16] * v; acc[7] += w[17] * v; acc[6] += w[18] * v; acc[5] += w[19] * v; acc[4] += w[20] * v; acc[3] += w[21] * v; acc[2] += w[22] * v; acc[1] += w[23] * v; acc[0] += w[24] * v; }
    { const unsigned u = lin0[25 * 512]; f32x2 v; v.x = bflo(u); v.y = bfhi(u); acc[25] += w[0] * v; acc[24] += w[1] * v; acc[23] += w[2] * v; acc[22] += w[3] * v; acc[21] += w[4] * v; acc[20] += w[5] * v; acc[19] += w[6] * v; acc[18] += w[7] * v; acc[17] += w[8] * v; acc[16] += w[9] * v; acc[15] += w[10] * v; acc[14] += w[11] * v; acc[13] += w[12] * v; acc[12] += w[13] * v; acc[11] += w[14] * v; acc[10] += w[15] * v; acc[9] += w[16] * v; acc[8] += w[17] * v; acc[7] += w[18] * v; acc[6] += w[19] * v; acc[5] += w[20] * v; acc[4] += w[21] * v; acc[3] += w[22] * v; acc[2] += w[23] * v; acc[1] += w[24] * v; acc[0] += w[25] * v; }
    asm volatile("" ::: "memory");
    { const unsigned u = lin0[26 * 512]; f32x2 v; v.x = bflo(u); v.y = bfhi(u); acc[26] += w[0] * v; acc[25] += w[1] * v; acc[24] += w[2] * v; acc[23] += w[3] * v; acc[22] += w[4] * v; acc[21] += w[5] * v; acc[20] += w[6] * v; acc[19] += w[7] * v; acc[18] += w[8] * v; acc[17] += w[9] * v; acc[16] += w[10] * v; acc[15] += w[11] * v; acc[14] += w[12] * v; acc[13] += w[13] * v; acc[12] += w[14] * v; acc[11] += w[15] * v; acc[10] += w[16] * v; acc[9] += w[17] * v; acc[8] += w[18] * v; acc[7] += w[19] * v; acc[6] += w[20] * v; acc[5] += w[21] * v; acc[4] += w[22] * v; acc[3] += w[23] * v; acc[2] += w[24] * v; acc[1] += w[25] * v; acc[0] += w[26] * v; }
    { const unsigned u = lin0[27 * 512]; f32x2 v; v.x = bflo(u); v.y = bfhi(u); acc[27] += w[0] * v; acc[26] += w[1] * v; acc[25] += w[2] * v; acc[24] += w[3] * v; acc[23] += w[4] * v; acc[22] += w[5] * v; acc[21] += w[6] * v; acc[20] += w[7] * v; acc[19] += w[8] * v; acc[18] += w[9] * v; acc[17] += w[10] * v; acc[16] += w[11] * v; acc[15] += w[12] * v; acc[14] += w[13] * v; acc[13] += w[14] * v; acc[12] += w[15] * v; acc[11] += w[16] * v; acc[10] += w[17] * v; acc[9] += w[18] * v; acc[8] += w[19] * v; acc[7] += w[20] * v; acc[6] += w[21] * v; acc[5] += w[22] * v; acc[4] += w[23] * v; acc[3] += w[24] * v; acc[2] += w[25] * v; acc[1] += w[26] * v; acc[0] += w[27] * v; }
    asm volatile("" ::: "memory");
    { const unsigned u = lin0[28 * 512]; f32x2 v; v.x = bflo(u); v.y = bfhi(u); acc[28] += w[0] * v; acc[27] += w[1] * v; acc[26] += w[2] * v; acc[25] += w[3] * v; acc[24] += w[4] * v; acc[23] += w[5] * v; acc[22] += w[6] * v; acc[21] += w[7] * v; acc[20] += w[8] * v; acc[19] += w[9] * v; acc[18] += w[10] * v; acc[17] += w[11] * v; acc[16] += w[12] * v; acc[15] += w[13] * v; acc[14] += w[14] * v; acc[13] += w[15] * v; acc[12] += w[16] * v; acc[11] += w[17] * v; acc[10] += w[18] * v; acc[9] += w[19] * v; acc[8] += w[20] * v; acc[7] += w[21] * v; acc[6] += w[22] * v; acc[5] += w[23] * v; acc[4] += w[24] * v; acc[3] += w[25] * v; acc[2] += w[26] * v; acc[1] += w[27] * v; acc[0] += w[28] * v; }
    { const unsigned u = lin0[29 * 512]; f32x2 v; v.x = bflo(u); v.y = bfhi(u); acc[29] += w[0] * v; acc[28] += w[1] * v; acc[27] += w[2] * v; acc[26] += w[3] * v; acc[25] += w[4] * v; acc[24] += w[5] * v; acc[23] += w[6] * v; acc[22] += w[7] * v; acc[21] += w[8] * v; acc[20] += w[9] * v; acc[19] += w[10] * v; acc[18] += w[11] * v; acc[17] += w[12] * v; acc[16] += w[13] * v; acc[15] += w[14] * v; acc[14] += w[15] * v; acc[13] += w[16] * v; acc[12] += w[17] * v; acc[11] += w[18] * v; acc[10] += w[19] * v; acc[9] += w[20] * v; acc[8] += w[21] * v; acc[7] += w[22] * v; acc[6] += w[23] * v; acc[5] += w[24] * v; acc[4] += w[25] * v; acc[3] += w[26] * v; acc[2] += w[27] * v; acc[1] += w[28] * v; acc[0] += w[29] * v; }
    asm volatile("" ::: "memory");
    { const unsigned u = lin0[30 * 512]; f32x2 v; v.x = bflo(u); v.y = bfhi(u); acc[30] += w[0] * v; acc[29] += w[1] * v; acc[28] += w[2] * v; acc[27] += w[3] * v; acc[26] += w[4] * v; acc[25] += w[5] * v; acc[24] += w[6] * v; acc[23] += w[7] * v; acc[22] += w[8] * v; acc[21] += w[9] * v; acc[20] += w[10] * v; acc[19] += w[11] * v; acc[18] += w[12] * v; acc[17] += w[13] * v; acc[16] += w[14] * v; acc[15] += w[15] * v; acc[14] += w[16] * v; acc[13] += w[17] * v; acc[12] += w[18] * v; acc[11] += w[19] * v; acc[10] += w[20] * v; acc[9] += w[21] * v; acc[8] += w[22] * v; acc[7] += w[23] * v; acc[6] += w[24] * v; acc[5] += w[25] * v; acc[4] += w[26] * v; acc[3] += w[27] * v; acc[2] += w[28] * v; acc[1] += w[29] * v; acc[0] += w[30] * v; }
    { const unsigned u = lin1[0 * 512]; f32x2 v; v.x = bflo(u); v.y = bfhi(u); acc[31] += w[0] * v; acc[30] += w[1] * v; acc[29] += w[2] * v; acc[28] += w[3] * v; acc[27] += w[4] * v; acc[26] += w[5] * v; acc[25] += w[6] * v; acc[24] += w[7] * v; acc[23] += w[8] * v; acc[22] += w[9] * v; acc[21] += w[10] * v; acc[20] += w[11] * v; acc[19] += w[12] * v; acc[18] += w[13] * v; acc[17] += w[14] * v; acc[16] += w[15] * v; acc[15] += w[16] * v; acc[14] += w[17] * v; acc[13] += w[18] * v; acc[12] += w[19] * v; acc[11] += w[20] * v; acc[10] += w[21] * v; acc[9] += w[22] * v; acc[8] += w[23] * v; acc[7] += w[24] * v; acc[6] += w[25] * v; acc[5] += w[26] * v; acc[4] += w[27] * v; acc[3] += w[28] * v; acc[2] += w[29] * v; acc[1] += w[30] * v; }
    asm volatile("" ::: "memory");
    { const unsigned u = lin1[1 * 512]; f32x2 v; v.x = bflo(u); v.y = bfhi(u); acc[31] += w[1] * v; acc[30] += w[2] * v; acc[29] += w[3] * v; acc[28] += w[4] * v; acc[27] += w[5] * v; acc[26] += w[6] * v; acc[25] += w[7] * v; acc[24] += w[8] * v; acc[23] += w[9] * v; acc[22] += w[10] * v; acc[21] += w[11] * v; acc[20] += w[12] * v; acc[19] += w[13] * v; acc[18] += w[14] * v; acc[17] += w[15] * v; acc[16] += w[16] * v; acc[15] += w[17] * v; acc[14] += w[18] * v; acc[13] += w[19] * v; acc[12] += w[20] * v; acc[11] += w[21] * v; acc[10] += w[22] * v; acc[9] += w[23] * v; acc[8] += w[24] * v; acc[7] += w[25] * v; acc[6] += w[26] * v; acc[5] += w[27] * v; acc[4] += w[28] * v; acc[3] += w[29] * v; acc[2] += w[30] * v; }
    { const unsigned u = lin1[2 * 512]; f32x2 v; v.x = bflo(u); v.y = bfhi(u); acc[31] += w[2] * v; acc[30] += w[3] * v; acc[29] += w[4] * v; acc[28] += w[5] * v; acc[27] += w[6] * v; acc[26] += w[7] * v; acc[25] += w[8] * v; acc[24] += w[9] * v; acc[23] += w[10] * v; acc[22] += w[11] * v; acc[21] += w[12] * v; acc[20] += w[13] * v; acc[19] += w[14] * v; acc[18] += w[15] * v; acc[17] += w[16] * v; acc[16] += w[17] * v; acc[15] += w[18] * v; acc[14] += w[19] * v; acc[13] += w[20] * v; acc[12] += w[21] * v; acc[11] += w[22] * v; acc[10] += w[23] * v; acc[9] += w[24] * v; acc[8] += w[25] * v; acc[7] += w[26] * v; acc[6] += w[27] * v; acc[5] += w[28] * v; acc[4] += w[29] * v; acc[3] += w[30] * v; }
    asm volatile("" ::: "memory");
    { const unsigned u = lin1[3 * 512]; f32x2 v; v.x = bflo(u); v.y = bfhi(u); acc[31] += w[3] * v; acc[30] += w[4] * v; acc[29] += w[5] * v; acc[28] += w[6] * v; acc[27] += w[7] * v; acc[26] += w[8] * v; acc[25] += w[9] * v; acc[24] += w[10] * v; acc[23] += w[11] * v; acc[22] += w[12] * v; acc[21] += w[13] * v; acc[20] += w[14] * v; acc[19] += w[15] * v; acc[18] += w[16] * v; acc[17] += w[17] * v; acc[16] += w[18] * v; acc[15] += w[19] * v; acc[14] += w[20] * v; acc[13] += w[21] * v; acc[12] += w[22] * v; acc[11] += w[23] * v; acc[10] += w[24] * v; acc[9] += w[25] * v; acc[8] += w[26] * v; acc[7] += w[27] * v; acc[6] += w[28] * v; acc[5] += w[29] * v; acc[4] += w[30] * v; }
    { const unsigned u = lin1[4 * 512]; f32x2 v; v.x = bflo(u); v.y = bfhi(u); acc[31] += w[4] * v; acc[30] += w[5] * v; acc[29] += w[6] * v; acc[28] += w[7] * v; acc[27] += w[8] * v; acc[26] += w[9] * v; acc[25] += w[10] * v; acc[24] += w[11] * v; acc[23] += w[12] * v; acc[22] += w[13] * v; acc[21] += w[14] * v; acc[20] += w[15] * v; acc[19] += w[16] * v; acc[18] += w[17] * v; acc[17] += w[18] * v; acc[16] += w[19] * v; acc[15] += w[20] * v; acc[14] += w[21] * v; acc[13] += w[22] * v; acc[12] += w[23] * v; acc[11] += w[24] * v; acc[10] += w[25] * v; acc[9] += w[26] * v; acc[8] += w[27] * v; acc[7] += w[28] * v; acc[6] += w[29] * v; acc[5] += w[30] * v; }
    asm volatile("" ::: "memory");
    { const unsigned u = lin1[5 * 512]; f32x2 v; v.x = bflo(u); v.y = bfhi(u); acc[31] += w[5] * v; acc[30] += w[6] * v; acc[29] += w[7] * v; acc[28] += w[8] * v; acc[27] += w[9] * v; acc[26] += w[10] * v; acc[25] += w[11] * v; acc[24] += w[12] * v; acc[23] += w[13] * v; acc[22] += w[14] * v; acc[21] += w[15] * v; acc[20] += w[16] * v; acc[19] += w[17] * v; acc[18] += w[18] * v; acc[17] += w[19] * v; acc[16] += w[20] * v; acc[15] += w[21] * v; acc[14] += w[22] * v; acc[13] += w[23] * v; acc[12] += w[24] * v; acc[11] += w[25] * v; acc[10] += w[26] * v; acc[9] += w[27] * v; acc[8] += w[28] * v; acc[7] += w[29] * v; acc[6] += w[30] * v; }
    { const unsigned u = lin1[6 * 512]; f32x2 v; v.x = bflo(u); v.y = bfhi(u); acc[31] += w[6] * v; acc[30] += w[7] * v; acc[29] += w[8] * v; acc[28] += w[9] * v; acc[27] += w[10] * v; acc[26] += w[11] * v; acc[25] += w[12] * v; acc[24] += w[13] * v; acc[23] += w[14] * v; acc[22] += w[15] * v; acc[21] += w[16] * v; acc[20] += w[17] * v; acc[19] += w[18] * v; acc[18] += w[19] * v; acc[17] += w[20] * v; acc[16] += w[21] * v; acc[15] += w[22] * v; acc[14] += w[23] * v; acc[13] += w[24] * v; acc[12] += w[25] * v; acc[11] += w[26] * v; acc[10] += w[27] * v; acc[9] += w[28] * v; acc[8] += w[29] * v; acc[7] += w[30] * v; }
    asm volatile("" ::: "memory");
    { const unsigned u = lin1[7 * 512]; f32x2 v; v.x = bflo(u); v.y = bfhi(u); acc[31] += w[7] * v; acc[30] += w[8] * v; acc[29] += w[9] * v; acc[28] += w[10] * v; acc[27] += w[11] * v; acc[26] += w[12] * v; acc[25] += w[13] * v; acc[24] += w[14] * v; acc[23] += w[15] * v; acc[22] += w[16] * v; acc[21] += w[17] * v; acc[20] += w[18] * v; acc[19] += w[19] * v; acc[18] += w[20] * v; acc[17] += w[21] * v; acc[16] += w[22] * v; acc[15] += w[23] * v; acc[14] += w[24] * v; acc[13] += w[25] * v; acc[12] += w[26] * v; acc[11] += w[27] * v; acc[10] += w[28] * v; acc[9] += w[29] * v; acc[8] += w[30] * v; }
    { const unsigned u = lin1[8 * 512]; f32x2 v; v.x = bflo(u); v.y = bfhi(u); acc[31] += w[8] * v; acc[30] += w[9] * v; acc[29] += w[10] * v; acc[28] += w[11] * v; acc[27] += w[12] * v; acc[26] += w[13] * v; acc[25] += w[14] * v; acc[24] += w[15] * v; acc[23] += w[16] * v; acc[22] += w[17] * v; acc[21] += w[18] * v; acc[20] += w[19] * v; acc[19] += w[20] * v; acc[18] += w[21] * v; acc[17] += w[22] * v; acc[16] += w[23] * v; acc[15] += w[24] * v; acc[14] += w[25] * v; acc[13] += w[26] * v; acc[12] += w[27] * v; acc[11] += w[28] * v; acc[10] += w[29] * v; acc[9] += w[30] * v; }
    asm volatile("" ::: "memory");
    { const unsigned u = lin1[9 * 512]; f32x2 v; v.x = bflo(u); v.y = bfhi(u); acc[31] += w[9] * v; acc[30] += w[10] * v; acc[29] += w[11] * v; acc[28] += w[12] * v; acc[27] += w[13] * v; acc[26] += w[14] * v; acc[25] += w[15] * v; acc[24] += w[16] * v; acc[23] += w[17] * v; acc[22] += w[18] * v; acc[21] += w[19] * v; acc[20] += w[20] * v; acc[19] += w[21] * v; acc[18] += w[22] * v; acc[17] += w[23] * v; acc[16] += w[24] * v; acc[15] += w[25] * v; acc[14] += w[26] * v; acc[13] += w[27] * v; acc[12] += w[28] * v; acc[11] += w[29] * v; acc[10] += w[30] * v; }
    { const unsigned u = lin1[10 * 512]; f32x2 v; v.x = bflo(u); v.y = bfhi(u); acc[31] += w[10] * v; acc[30] += w[11] * v; acc[29] += w[12] * v; acc[28] += w[13] * v; acc[27] += w[14] * v; acc[26] += w[15] * v; acc[25] += w[16] * v; acc[24] += w[17] * v; acc[23] += w[18] * v; acc[22] += w[19] * v; acc[21] += w[20] * v; acc[20] += w[21] * v; acc[19] += w[22] * v; acc[18] += w[23] * v; acc[17] += w[24] * v; acc[16] += w[25] * v; acc[15] += w[26] * v; acc[14] += w[27] * v; acc[13] += w[28] * v; acc[12] += w[29] * v; acc[11] += w[30] * v; }
    asm volatile("" ::: "memory");
    { const unsigned u = lin1[11 * 512]; f32x2 v; v.x = bflo(u); v.y = bfhi(u); acc[31] += w[11] * v; acc[30] += w[12] * v; acc[29] += w[13] * v; acc[28] += w[14] * v; acc[27] += w[15] * v; acc[26] += w[16] * v; acc[25] += w[17] * v; acc[24] += w[18] * v; acc[23] += w[19] * v; acc[22] += w[20] * v; acc[21] += w[21] * v; acc[20] += w[22] * v; acc[19] += w[23] * v; acc[18] += w[24] * v; acc[17] += w[25] * v; acc[16] += w[26] * v; acc[15] += w[27] * v; acc[14] += w[28] * v; acc[13] += w[29] * v; acc[12] += w[30] * v; }
    { const unsigned u = lin1[12 * 512]; f32x2 v; v.x = bflo(u); v.y = bfhi(u); acc[31] += w[12] * v; acc[30] += w[13] * v; acc[29] += w[14] * v; acc[28] += w[15] * v; acc[27] += w[16] * v; acc[26] += w[17] * v; acc[25] += w[18] * v; acc[24] += w[19] * v; acc[23] += w[20] * v; acc[22] += w[21] * v; acc[21] += w[22] * v; acc[20] += w[23] * v; acc[19] += w[24] * v; acc[18] += w[25] * v; acc[17] += w[26] * v; acc[16] += w[27] * v; acc[15] += w[28] * v; acc[14] += w[29] * v; acc[13] += w[30] * v; }
    asm volatile("" ::: "memory");
    { const unsigned u = lin1[13 * 512]; f32x2 v; v.x = bflo(u); v.y = bfhi(u); acc[31] += w[13] * v; acc[30] += w[14] * v; acc[29] += w[15] * v; acc[28] += w[16] * v; acc[27] += w[17] * v; acc[26] += w[18] * v; acc[25] += w[19] * v; acc[24] += w[20] * v; acc[23] += w[21] * v; acc[22] += w[22] * v; acc[21] += w[23] * v; acc[20] += w[24] * v; acc[19] += w[25] * v; acc[18] += w[26] * v; acc[17] += w[27] * v; acc[16] += w[28] * v; acc[15] += w[29] * v; acc[14] += w[30] * v; }
    { const unsigned u = lin1[14 * 512]; f32x2 v; v.x = bflo(u); v.y = bfhi(u); acc[31] += w[14] * v; acc[30] += w[15] * v; acc[29] += w[16] * v; acc[28] += w[17] * v; acc[27] += w[18] * v; acc[26] += w[19] * v; acc[25] += w[20] * v; acc[24] += w[21] * v; acc[23] += w[22] * v; acc[22] += w[23] * v; acc[21] += w[24] * v; acc[20] += w[25] * v; acc[19] += w[26] * v; acc[18] += w[27] * v; acc[17] += w[28] * v; acc[16] += w[29] * v; acc[15] += w[30] * v; }
    asm volatile("" ::: "memory");
    { const unsigned u = lin1[15 * 512]; f32x2 v; v.x = bflo(u); v.y = bfhi(u); acc[31] += w[15] * v; acc[30] += w[16] * v; acc[29] += w[17] * v; acc[28] += w[18] * v; acc[27] += w[19] * v; acc[26] += w[20] * v; acc[25] += w[21] * v; acc[24] += w[22] * v; acc[23] += w[23] * v; acc[22] += w[24] * v; acc[21] += w[25] * v; acc[20] += w[26] * v; acc[19] += w[27] * v; acc[18] += w[28] * v; acc[17] += w[29] * v; acc[16] += w[30] * v; }
    { const unsigned u = lin1[16 * 512]; f32x2 v; v.x = bflo(u); v.y = bfhi(u); acc[31] += w[16] * v; acc[30] += w[17] * v; acc[29] += w[18] * v; acc[28] += w[19] * v; acc[27] += w[20] * v; acc[26] += w[21] * v; acc[25] += w[22] * v; acc[24] += w[23] * v; acc[23] += w[24] * v; acc[22] += w[25] * v; acc[21] += w[26] * v; acc[20] += w[27] * v; acc[19] += w[28] * v; acc[18] += w[29] * v; acc[17] += w[30] * v; }
    asm volatile("" ::: "memory");
    { const unsigned u = lin1[17 * 512]; f32x2 v; v.x = bflo(u); v.y = bfhi(u); acc[31] += w[17] * v; acc[30] += w[18] * v; acc[29] += w[19] * v; acc[28] += w[20] * v; acc[27] += w[21] * v; acc[26] += w[22] * v; acc[25] += w[23] * v; acc[24] += w[24] * v; acc[23] += w[25] * v; acc[22] += w[26] * v; acc[21] += w[27] * v; acc[20] += w[28] * v; acc[19] += w[29] * v; acc[18] += w[30] * v; }
    { const unsigned u = lin1[18 * 512]; f32x2 v; v.x = bflo(u); v.y = bfhi(u); acc[31] += w[18] * v; acc[30] += w[19] * v; acc[29] += w[20] * v; acc[28] += w[21] * v; acc[27] += w[22] * v; acc[26] += w[23] * v; acc[25] += w[24] * v; acc[24] += w[25] * v; acc[23] += w[26] * v; acc[22] += w[27] * v; acc[21] += w[28] * v; acc[20] += w[29] * v; acc[19] += w[30] * v; }
    asm volatile("" ::: "memory");
    { const unsigned u = lin1[19 * 512]; f32x2 v; v.x = bflo(u); v.y = bfhi(u); acc[31] += w[19] * v; acc[30] += w[20] * v; acc[29] += w[21] * v; acc[28] += w[22] * v; acc[27] += w[23] * v; acc[26] += w[24] * v; acc[25] += w[25] * v; acc[24] += w[26] * v; acc[23] += w[27] * v; acc[22] += w[28] * v; acc[21] += w[29] * v; acc[20] += w[30] * v; }
    { const unsigned u = lin1[20 * 512]; f32x2 v; v.x = bflo(u); v.y = bfhi(u); acc[31] += w[20] * v; acc[30] += w[21] * v; acc[29] += w[22] * v; acc[28] += w[23] * v; acc[27] += w[24] * v; acc[26] += w[25] * v; acc[25] += w[26] * v; acc[24] += w[27] * v; acc[23] += w[28] * v; acc[22] += w[29] * v; acc[21] += w[30] * v; }
    asm volatile("" ::: "memory");
    { const unsigned u = lin1[21 * 512]; f32x2 v; v.x = bflo(u); v.y = bfhi(u); acc[31] += w[21] * v; acc[30] += w[22] * v; acc[29] += w[23] * v; acc[28] += w[24] * v; acc[27] += w[25] * v; acc[26] += w[26] * v; acc[25] += w[27] * v; acc[24] += w[28] * v; acc[23] += w[29] * v; acc[22] += w[30] * v; }
    { const unsigned u = lin1[22 * 512]; f32x2 v; v.x = bflo(u); v.y = bfhi(u); acc[31] += w[22] * v; acc[30] += w[23] * v; acc[29] += w[24] * v; acc[28] += w[25] * v; acc[27] += w[26] * v; acc[26] += w[27] * v; acc[25] += w[28] * v; acc[24] += w[29] * v; acc[23] += w[30] * v; }
    asm volatile("" ::: "memory");
    { const unsigned u = lin1[23 * 512]; f32x2 v; v.x = bflo(u); v.y = bfhi(u); acc[31] += w[23] * v; acc[30] += w[24] * v; acc[29] += w[25] * v; acc[28] += w[26] * v; acc[27] += w[27] * v; acc[26] += w[28] * v; acc[25] += w[29] * v; acc[24] += w[30] * v; }
    { const unsigned u = lin1[24 * 512]; f32x2 v; v.x = bflo(u); v.y = bfhi(u); acc[31] += w[24] * v; acc[30] += w[25] * v; acc[29] += w[26] * v; acc[28] += w[27] * v; acc[27] += w[28] * v; acc[26] += w[29] * v; acc[25] += w[30] * v; }
    asm volatile("" ::: "memory");
    { const unsigned u = lin1[25 * 512]; f32x2 v; v.x = bflo(u); v.y = bfhi(u); acc[31] += w[25] * v; acc[30] += w[26] * v; acc[29] += w[27] * v; acc[28] += w[28] * v; acc[27] += w[29] * v; acc[26] += w[30] * v; }
    { const unsigned u = lin1[26 * 512]; f32x2 v; v.x = bflo(u); v.y = bfhi(u); acc[31] += w[26] * v; acc[30] += w[27] * v; acc[29] += w[28] * v; acc[28] += w[29] * v; acc[27] += w[30] * v; }
    asm volatile("" ::: "memory");
    { const unsigned u = lin1[27 * 512]; f32x2 v; v.x = bflo(u); v.y = bfhi(u); acc[31] += w[27] * v; acc[30] += w[28] * v; acc[29] += w[29] * v; acc[28] += w[30] * v; }
    { const unsigned u = lin1[28 * 512]; f32x2 v; v.x = bflo(u); v.y = bfhi(u); acc[31] += w[28] * v; acc[30] += w[29] * v; acc[29] += w[30] * v; }
    asm volatile("" ::: "memory");
    { const unsigned u = lin1[29 * 512]; f32x2 v; v.x = bflo(u); v.y = bfhi(u); acc[31] += w[29] * v; acc[30] += w[30] * v; }
    { const unsigned u = lin1[30 * 512]; f32x2 v; v.x = bflo(u); v.y = bfhi(u); acc[31] += w[30] * v; }
    asm volatile("" ::: "memory");
    __syncthreads();
#pragma unroll
    for (int t = 0; t < 32; ++t) part[t * 520 + tid] = acc[t].x + acc[t].y;
    __syncthreads();
    { const int tk = tid >> 4, sub = tid & 15; float s = 0.f;
#pragma unroll 8
        for (int i = 0; i < 32; ++i) s += part[tk * 520 + sub + 16 * i];
        s += __shfl_xor(s, 1); s += __shfl_xor(s, 2); s += __shfl_xor(s, 4); s += __shfl_xor(s, 8);
        if (sub == 0) stat[tk] = s * (1.f / 1024.f); }
    __syncthreads();
#pragma unroll
    for (int t = 0; t < 32; ++t) { const float m = stat[t]; acc[t].x -= m; acc[t].y -= m; }
    __syncthreads();
#pragma unroll
    for (int t = 0; t < 32; ++t) part[t * 520 + tid] = acc[t].x * acc[t].x + acc[t].y * acc[t].y;
    __syncthreads();
    { const int tk = tid >> 4, sub = tid & 15; float s = 0.f;
#pragma unroll 8
        for (int i = 0; i < 32; ++i) s += part[tk * 520 + sub + 16 * i];
        s += __shfl_xor(s, 1); s += __shfl_xor(s, 2); s += __shfl_xor(s, 4); s += __shfl_xor(s, 8);
        if (sub == 0) stat[tk] = 1.f / sqrtf(s * (1.f / 1024.f) + LN_EPS); }
    __syncthreads();
    const f32x2 lg = *(const f32x2*)(a.in[I_CLNG] + c), lb = *(const f32x2*)(a.in[I_CLNB] + c);
#pragma unroll
    for (int t = 0; t < 32; ++t) { const float rs = stat[t]; float y0 = acc[t].x * rs * lg.x + lb.x, y1 = acc[t].y * rs * lg.y + lb.y; y0 *= sigm(y0); y1 *= sigm(y1);
        *(unsigned*)(CAT + (size_t)(r0 + t) * 2048 + c) = pk(y0, y1); }
    __syncthreads();
    (void)lane;
}
#ifdef NO_S5
#define S5CALL(x)
#else
#define S5CALL(x) x
#endif
#ifdef NO_CONV
#define CONVCALL(x)
#else
#define CONVCALL(x) x
#endif
__device__ __forceinline__ void p_s5_conv(const Args& a, unsigned char* lds, int bid, int G) {
    if (G >= 64) {
        if (bid < 32) { S5CALL(s5_block(a, lds, true, bid)); return; }
        for (int tk = bid - 32; tk < 512; tk += G - 32) { S5CALL(s5_block(a, lds, false, tk)); }
    } else {
        for (int tk = bid; tk < 544; tk += G) { if (tk < 32) { S5CALL(s5_block(a, lds, true, tk)); } else { S5CALL(s5_block(a, lds, false, tk - 32)); } }
    }
}

__device__ __forceinline__ bf16x8 pack8(const f32x16& p, int o) {
    return __builtin_bit_cast(bf16x8, (u32x4){pk(p[o], p[o + 1]), pk(p[o + 2], p[o + 3]), pk(p[o + 4], p[o + 5]), pk(p[o + 6], p[o + 7])});
}
__device__ __forceinline__ void attn_unit(const Args& a, unsigned char* lds, bool sample, int b, int h, int qb, float lam, float out_scale) {
    const int tid = threadIdx.x, lane = tid & 63, wave = tid >> 6, r32 = lane & 31, hi = lane >> 5, mp = wave >> 2, wq = wave & 3;
    const int nk = sample ? 2560 : 256, nt = nk / 64;
    const bf16* K0 = sample ? (const bf16*)(a.ws + WS_KS) + (size_t)(b * 32 + h) * 2560 * 64 : (const bf16*)(a.ws + WS_KP) + (size_t)(b * 32 + h) * 256 * 64;
    const bf16* K1 = K0 + (size_t)16 * nk * 64;
    const bf16* VT = sample ? (const bf16*)(a.ws + WS_VTS) + (size_t)(b * 16 + h) * 128 * 2560 : (const bf16*)(a.ws + WS_VTP) + (size_t)(b * 16 + h) * 128 * 256;
    const int qrow0 = (sample ? TP + b * 2048 : b * 256) + qb * 128 + wq * 32;
    const bf16* QB = (const bf16*)(a.ws + WS_QB);
    bf16x8 qf[4];
#pragma unroll
    for (int d0 = 0; d0 < 4; ++d0) qf[d0] = *(const bf16x8*)(QB + (size_t)(qrow0 + r32) * 2048 + mp * 1024 + h * 64 + d0 * 16 + hi * 8);
    f32x16 O[4];
#pragma unroll
    for (int d = 0; d < 4; ++d)
#pragma unroll
        for (int r = 0; r < 16; ++r) O[d][r] = 0.f;
    float mrun = -1e30f, lsum = 0.f;
    float* xch = (float*)(lds + 73728);
    const int skey = tid >> 3, sc = tid & 7;
    const unsigned char* kb = lds + mp * 9216 + r32 * 144 + hi * 16;
    const unsigned char* vb = lds + 18432 + r32 * 144 + hi * 16;
    unsigned char* skp = lds + skey * 144 + sc * 16;
    unsigned char* svp = lds + 18432 + skey * 144 + (16 * (sc >> 1) + 4 * (sc & 1)) * 2;
    u32x4 sk0, sk1, sv0, sv1;
#define ATT_LOAD(kt) do { sk0 = *(const u32x4*)(K0 + (size_t)((kt) * 64 + skey) * 64 + sc * 8); sk1 = *(const u32x4*)(K1 + (size_t)((kt) * 64 + skey) * 64 + sc * 8); \
        sv0 = *(const u32x4*)(VT + (size_t)skey * nk + (kt) * 64 + sc * 8); sv1 = *(const u32x4*)(VT + (size_t)(64 + skey) * nk + (kt) * 64 + sc * 8); } while (0)
#define ATT_STORE(BO) do { *(u32x4*)(skp + (BO)) = sk0; *(u32x4*)(skp + (BO) + 9216) = sk1; \
        *(u32x2*)(svp + (BO)) = (u32x2){sv0.x, sv0.y}; *(u32x2*)(svp + (BO) + 16) = (u32x2){sv0.z, sv0.w}; \
        *(u32x2*)(svp + (BO) + 9216) = (u32x2){sv1.x, sv1.y}; *(u32x2*)(svp + (BO) + 9232) = (u32x2){sv1.z, sv1.w}; } while (0)
    ATT_LOAD(0); VM_DRAIN(); ATT_STORE(0); ATT_LOAD(1);
    __syncthreads();
    for (int kt = 0; kt < nt; kt += 2) {
        { VM_DRAIN(); ATT_STORE(36864); if (kt + 2 < nt) ATT_LOAD(kt + 2); }
        {
        f32x16 p0, p1;
#pragma unroll
        for (int r = 0; r < 16; ++r) { p0[r] = 0.f; p1[r] = 0.f; }
#pragma unroll
        for (int d0 = 0; d0 < 4; ++d0) { const bf16x8 k0 = *(const bf16x8*)(kb + 0 + d0 * 32), k1 = *(const bf16x8*)(kb + 4608 + d0 * 32);
            p0 = __builtin_amdgcn_mfma_f32_32x32x16_bf16(k0, qf[d0], p0, 0, 0, 0); p1 = __builtin_amdgcn_mfma_f32_32x32x16_bf16(k1, qf[d0], p1, 0, 0, 0); }
        asm volatile("s_nop 15\n\ts_nop 15" : "+v"(p0), "+v"(p1));
        float mx = fmaxf(p0[0], p1[0]);
#pragma unroll
        for (int r = 1; r < 16; ++r) mx = fmaxf(mx, fmaxf(p0[r], p1[r]));
        mx = fmaxf(mx, __shfl_xor(mx, 32));
        const float mnew = fmaxf(mrun, mx), f = __builtin_amdgcn_exp2f(mrun - mnew); mrun = mnew;
        float s = 0.f;
#pragma unroll
        for (int r = 0; r < 16; ++r) { p0[r] = __builtin_amdgcn_exp2f(p0[r] - mnew); p1[r] = __builtin_amdgcn_exp2f(p1[r] - mnew); s += p0[r] + p1[r]; }
        lsum = lsum * f + s;
        if (__any(f != 1.0f)) {
#pragma unroll
            for (int d = 0; d < 4; ++d)
#pragma unroll
                for (int r = 0; r < 16; ++r) O[d][r] *= f; }
        bf16x8 pa[4]; pa[0] = pack8(p0, 0); pa[1] = pack8(p0, 8); pa[2] = pack8(p1, 0); pa[3] = pack8(p1, 8);
#pragma unroll
        for (int d = 0; d < 4; ++d)
#pragma unroll
            for (int s2 = 0; s2 < 4; ++s2) { const bf16x8 va = *(const bf16x8*)(vb + 0 + d * 4608 + s2 * 32);
                O[d] = __builtin_amdgcn_mfma_f32_32x32x16_bf16(va, pa[s2], O[d], 0, 0, 0); }
        }
        __syncthreads();
        if (kt + 2 < nt) { VM_DRAIN(); ATT_STORE(0); if (kt + 3 < nt) ATT_LOAD(kt + 3); }
        {
        f32x16 p0, p1;
#pragma unroll
        for (int r = 0; r < 16; ++r) { p0[r] = 0.f; p1[r] = 0.f; }
#pragma unroll
        for (int d0 = 0; d0 < 4; ++d0) { const bf16x8 k0 = *(const bf16x8*)(kb + 36864 + d0 * 32), k1 = *(const bf16x8*)(kb + 41472 + d0 * 32);
            p0 = __builtin_amdgcn_mfma_f32_32x32x16_bf16(k0, qf[d0], p0, 0, 0, 0); p1 = __builtin_amdgcn_mfma_f32_32x32x16_bf16(k1, qf[d0], p1, 0, 0, 0); }
        asm volatile("s_nop 15\n\ts_nop 15" : "+v"(p0), "+v"(p1));
        float mx = fmaxf(p0[0], p1[0]);
#pragma unroll
        for (int r = 1; r < 16; ++r) mx = fmaxf(mx, fmaxf(p0[r], p1[r]));
        mx = fmaxf(mx, __shfl_xor(mx, 32));
        const float mnew = fmaxf(mrun, mx), f = __builtin_amdgcn_exp2f(mrun - mnew); mrun = mnew;
        float s = 0.f;
#pragma unroll
        for (int r = 0; r < 16; ++r) { p0[r] = __builtin_amdgcn_exp2f(p0[r] - mnew); p1[r] = __builtin_amdgcn_exp2f(p1[r] - mnew); s += p0[r] + p1[r]; }
        lsum = lsum * f + s;
        if (__any(f != 1.0f)) {
#pragma unroll
            for (int d = 0; d < 4; ++d)
#pragma unroll
                for (int r = 0; r < 16; ++r) O[d][r] *= f; }
        bf16x8 pa[4]; pa[0] = pack8(p0, 0); pa[1] = pack8(p0, 8); pa[2] = pack8(p1, 0); pa[3] = pack8(p1, 8);
#pragma unroll
        for (int d = 0; d < 4; ++d)
#pragma unroll
            for (int s2 = 0; s2 < 4; ++s2) { const bf16x8 va = *(const bf16x8*)(vb + 36864 + d * 4608 + s2 * 32);
                O[d] = __builtin_amdgcn_mfma_f32_32x32x16_bf16(va, pa[s2], O[d], 0, 0, 0); }
        }
        __syncthreads();
    }
#undef ATT_LOAD
#undef ATT_STORE
    asm volatile("s_nop 15\n\ts_nop 15" : "+v"(O[0]), "+v"(O[1]), "+v"(O[2]), "+v"(O[3]));
    const float lt = lsum + __shfl_xor(lsum, 32);
    const float inv = (mp ? lam : 1.f) / lt;
    if (mp) {
#pragma unroll
        for (int d = 0; d < 4; ++d)
#pragma unroll
            for (int r = 0; r < 16; ++r) xch[(wq * 64 + d * 16 + r) * 64 + lane] = O[d][r] * inv;
    }
    __syncthreads();
    if (!mp) {
        float ss = 0.f;
#pragma unroll
        for (int d = 0; d < 4; ++d)
#pragma unroll
            for (int r = 0; r < 16; ++r) { const float o = O[d][r] * inv - xch[(wq * 64 + d * 16 + r) * 64 + lane]; O[d][r] = o; ss += o * o; }
        ss += __shfl_xor(ss, 32);
        const float rinv = 1.f / sqrtf(ss * (1.f / 128.f) + LN_EPS); (void)out_scale;
        unsigned char* stg = (unsigned char*)xch + wq * 16384;
#pragma unroll
        for (int d = 0; d < 4; ++d)
#pragma unroll
            for (int r = 0; r < 16; ++r) { const int dv = d * 32 + crow(r, hi); *(bf16*)(stg + r32 * 272 + dv * 2) = (bf16)pk(O[d][r] * rinv, 0.f); }
        LDS_FENCE();
        bf16* OA = (bf16*)(a.ws + WS_OA);
#pragma unroll
        for (int i = 0; i < 8; ++i) { const int id = lane + 64 * i, row = id >> 4, ch = id & 15; const u32x4 v = *(const u32x4*)(stg + row * 272 + ch * 16);
            *(u32x4*)(OA + (size_t)(qrow0 + row) * 2048 + h * 128 + ch * 8) = v; }
    }
}
__device__ __forceinline__ void p_attn(const Args& a, unsigned char* lds, int bid, int G) {
    const int lane = threadIdx.x & 63;
    const float lam_init = 0.8f - 0.6f * expf(-0.3f);
    const float d1 = wave_sum(a.in[I_LQ1][lane] * a.in[I_LK1][lane]), d2 = wave_sum(a.in[I_LQ2][lane] * a.in[I_LK2][lane]);
    const float lam = expf(d1) - expf(d2) + lam_init, osc = 1.f - lam_init;
    for (int tk = bid; tk < 1536; tk += G) {
        if (tk < 512) { int bh, qb; if (G == 256) { const int t2 = tk & 255; bh = (t2 & 7) * 4 + (t2 >> 6); qb = ((t2 >> 3) & 7) * 2 + (tk >> 8); } else { bh = tk >> 4; qb = tk & 15; }
            attn_unit(a, lds, true, bh >> 4, bh & 15, qb, lam, osc); }
        else { const int u = tk - 512; attn_unit(a, lds, false, u >> 5, (u >> 1) & 15, u & 1, lam, osc); }
    }
}
__device__ __forceinline__ void p_cache(const Args& a, unsigned char* lds, int bid, int G) {
    const int tid = threadIdx.x, lane = tid & 63, wave = tid >> 6;
    bf16* KS = (bf16*)(a.ws + WS_KS); bf16* VTS = (bf16*)(a.ws + WS_VTS);
    for (int e = bid * NTHR + tid; e < 262144; e += G * NTHR) {
        const int bmh = e >> 12, j = (e >> 3) & 511, d = (e & 7) * 8; const float* s = a.in[I_CK] + (size_t)e * 8;
        const f32x4 x0 = *(const f32x4*)s, x1 = *(const f32x4*)(s + 4); VM_DRAIN();
        *(u32x4*)(KS + ((size_t)bmh * 2560 + 2048 + j) * 64 + d) = (u32x4){pk(x0[0], x0[1]), pk(x0[2], x0[3]), pk(x1[0], x1[1]), pk(x1[2], x1[3])}; }
    float* scr = (float*)(lds + wave * 8704);
    for (int it = bid * NWAVE + wave; it < 1024; it += G * NWAVE) {
        const int bh = it >> 5, r = it & 31, kb = r >> 2, nb = r & 3;
        transpose_item(a.in[I_CV] + (size_t)bh * 512 * 128, 128, 64 * kb, 32 * nb, VTS + (size_t)bh * 128 * 2560, 2560, 32 * nb, 2048 + 64 * kb, scr, lane); }
    __syncthreads();
}

#define LAS __attribute__((address_space(3)))
#define XB_TMO      128
#define XB_XCNT(j)  (256  + 64 * (j))
#define XB_XSUB(j)  (1280 + 64 * (j))
#define XB_XGEN(j)  (2304 + 64 * (j))
#define XB_TOP      3328
#define XB_TOPGEN   3392
#define XCD_BAR_WORDS 3456
#define XB_SPIN_CAP (1u << 18)

__device__ __forceinline__ unsigned xb_ld(unsigned* p)              { return __hip_atomic_load(p, __ATOMIC_RELAXED, __HIP_MEMORY_SCOPE_AGENT); }
__device__ __forceinline__ unsigned xb_add(unsigned* p, unsigned v) { return __hip_atomic_fetch_add(p, v, __ATOMIC_RELAXED, __HIP_MEMORY_SCOPE_AGENT); }
__device__ __forceinline__ unsigned xb_xcc_id() { return (unsigned)__builtin_amdgcn_s_getreg((3 << 11) | 20) & 0xFu; }
#define XB_SPIN(cond, bar) do { unsigned _sp = 0; while (cond) { __builtin_amdgcn_s_sleep(1); \
    if ((++_sp & 255u) == 0u) { if (xb_ld(&(bar)[XB_TMO])) break; if (_sp > XB_SPIN_CAP) { atomicAdd(&(bar)[XB_TMO], 1u); break; } } } } while (0)

struct XcdBarrier {
    unsigned* bar; unsigned x;
    volatile LAS unsigned* st;
};

__device__ __forceinline__ XcdBarrier xcd_barrier_post(unsigned* bar, volatile LAS unsigned* st) {
    XcdBarrier b; b.bar = bar; b.x = xb_xcc_id(); b.st = st;
    if (threadIdx.x == 0) (void)xb_add(&bar[XB_XCNT(b.x)], 1u);
    return b;
}
__device__ __forceinline__ void xcd_barrier_complete(unsigned* bar, unsigned x, unsigned& nloc, unsigned& nx) {
    const unsigned G = gridDim.x * gridDim.y * gridDim.z;
    unsigned sum, cnt, mine, sp = 0u;
    for (;;) {
        sum = 0u; cnt = 0u; mine = 0u;
#pragma unroll
        for (unsigned j = 0; j < 16; ++j) { const unsigned c = xb_ld(&bar[XB_XCNT(j)]); sum += c; cnt += (c > 0u) ? 1u : 0u; mine = (j == x) ? c : mine; }
        if (sum == G) break;
        __builtin_amdgcn_s_sleep(1);
        if ((++sp & 255u) == 0u) { if (xb_ld(&bar[XB_TMO])) break; if (sp > XB_SPIN_CAP) { atomicAdd(&bar[XB_TMO], 1u); break; } }
    }
    nloc = mine > 0u ? mine : 1u; nx = cnt > 0u ? cnt : 1u;
}

__device__ __forceinline__ void xcd_barrier(const XcdBarrier& b) {
    asm volatile("s_waitcnt vmcnt(0)" ::: "memory");
    __syncthreads();
    if (threadIdx.x == 0) {
        unsigned* bar = b.bar;
        __builtin_amdgcn_s_waitcnt(0);
        unsigned nloc = b.st[0], nx = b.st[1];
        if (nloc == 0u) { xcd_barrier_complete(bar, b.x, nloc, nx); b.st[0] = nloc; b.st[1] = nx; }
        const unsigned old = xb_add(&bar[XB_XSUB(b.x)], 1u);
        const unsigned gen = old / nloc;
        if (old + 1u == (gen + 1u) * nloc) {
            __builtin_amdgcn_fence(__ATOMIC_RELEASE, "agent");
            asm volatile("s_waitcnt vmcnt(0)" ::: "memory");
            const unsigned og = xb_add(&bar[XB_TOP], 1u);
            const unsigned tg = og / nx;
            if (og + 1u == (tg + 1u) * nx) xb_add(&bar[XB_TOPGEN], 1u);
            else XB_SPIN(xb_ld(&bar[XB_TOPGEN]) == tg, bar);
            __builtin_amdgcn_fence(__ATOMIC_ACQUIRE, "agent");
            xb_add(&bar[XB_XGEN(b.x)], 1u);
            asm volatile("s_waitcnt vmcnt(0)" ::: "memory");
        } else {
            XB_SPIN(xb_ld(&bar[XB_XGEN(b.x)]) == gen, bar);
            __builtin_amdgcn_fence(__ATOMIC_ACQUIRE, "agent");
            asm volatile("s_waitcnt vmcnt(0)" ::: "memory");
        }
    }
    __syncthreads();
}

constexpr size_t WS_BAR = 704 * 1024;
constexpr int NPHASE = 17;
__global__ void __launch_bounds__(NTHR, 2) fwd_mega(Args a) {
    extern __shared__ __attribute__((aligned(16))) unsigned char lds[];
    cg::grid_group grid = cg::this_grid();
    const int bid = blockIdx.x, G = gridDim.x;
    const int lo = a.ph_lo, hi = a.ph_hi;
    const float* MOD = (const float*)(a.ws + WS_MOD);
    volatile LAS unsigned* bst = (volatile LAS unsigned*)((LAS unsigned char*)lds + 140032);
    if (threadIdx.x < 2) bst[threadIdx.x] = 0u;
    __syncthreads();
    if (MK_BAR && hi - lo > 1) {
        if (bid == 0) { for (int e = threadIdx.x; e < XCD_BAR_WORDS; e += NTHR) __hip_atomic_store((unsigned*)(a.ws + WS_BAR) + e, 0u, __ATOMIC_RELAXED, __HIP_MEMORY_SCOPE_AGENT); __threadfence(); }
        grid.sync();
    }
    XcdBarrier xbar; xbar.bar = (unsigned*)(a.ws + WS_BAR); xbar.x = 0; xbar.st = bst;
    if (MK_BAR && hi - lo > 1) xbar = xcd_barrier_post((unsigned*)(a.ws + WS_BAR), bst);
    PG8_LAS unsigned char* glds = (PG8_LAS unsigned char*)lds;
#ifndef PH_MASK
#define PH_MASK 0x1ffff
#endif
#define IN(k) (((PH_MASK >> (k)) & 1) && lo <= (k) && (k) < hi)
#define SEAM(k) do { if (IN(k) && IN((k) + 1)) { if (MK_BAR) xcd_barrier(xbar); else grid.sync(); } } while (0)
#define GEMM_PHASE(EPI, EOBJ, Aoff, Boff, N_, K_) do { pg8::Gemm g{(const pg8::bf16_t*)(a.ws + (Aoff)), (const pg8::bf16_t*)(a.ws + (Boff)), TR, (N_), (K_)}; pg8::StaticOrder S; S.init(TR, (N_), G, bid); \
        pg8::gemm_phase<EPI, pg8::StaticOrder, true, true>(glds, g, S, EOBJ); } while (0)

#define GEMM_SPLIT2(Aoff, Boff, K_) do { pg8::Gemm g{(const pg8::bf16_t*)(a.ws + (Aoff)), (const pg8::bf16_t*)(a.ws + (Boff)), TR, 4096, (K_), (K_) / 2, 8}; pg8::StaticOrder S; S.init(TR, 4096, G, bid); \
        pg8::EpiSplit E{(pg8::bf16_t*)(a.ws + WS_F), (pg8::bf16_t*)(a.ws + WS_F2)}; pg8::gemm_phase<pg8::EpiSplit, pg8::StaticOrder, true, true>(glds, g, S, E); } while (0)
    if (IN(0)) { p0_prep(a, lds, bid, G); } SEAM(0);
    if (IN(1)) { p_mod_in(a, bid, G); } SEAM(1);
    if (IN(2)) { pg8::EpiIn E{(pg8::bf16_t*)(a.ws + WS_UG), (pg8::bf16_t*)(a.ws + WS_US)}; GEMM_PHASE(pg8::EpiIn, E, WS_H, WS_WIN, 3072, 2048); } SEAM(2);
    if (IN(3)) { p_s5_conv(a, lds, bid, G); } SEAM(3);
    if (IN(4)) { pg8::EpiGlu E{(const pg8::bf16_t*)(a.ws + WS_YS), (pg8::bf16_t*)(a.ws + WS_CAT)}; GEMM_PHASE(pg8::EpiGlu, E, WS_YS, WS_WGLU, 1024, 1024);
        __syncthreads();
        for (int tk = G - 1 - bid; tk < 384; tk += G) { CONVCALL(conv_tile(a, lds, tk)); } } SEAM(4);
    if (IN(5)) { GEMM_SPLIT2(WS_CAT, WS_WOAB, 2048); } SEAM(5);
    if (IN(6)) { p_ln(a, bid, G, true, MOD + 2 * 2048, a.in[I_LNG], a.in[I_LNB], MOD + 3 * 2048); } SEAM(6);
    if (IN(7)) { pg8::EpiPlain<1> E{(pg8::bf16_t*)(a.ws + WS_A2), 8192}; GEMM_PHASE(pg8::EpiPlain<1>, E, WS_H, WS_WF1, 8192, 2048); } SEAM(7);
    if (IN(8)) { GEMM_SPLIT2(WS_A2, WS_WF2, 8192); } SEAM(8);
    if (IN(9)) { p_ln(a, bid, G, false, MOD + 5 * 2048, a.in[I_LNG] + 2048, a.in[I_LNB] + 2048, MOD + 3 * 12288 + 0 * 2048); } SEAM(9);
    if (IN(10)) { p_cache(a, lds, bid, G);
        pg8::EpiQkv E{(pg8::bf16_t*)(a.ws + WS_QB), (pg8::bf16_t*)(a.ws + WS_KP), (pg8::bf16_t*)(a.ws + WS_VTP), (pg8::bf16_t*)(a.ws + WS_KS), (pg8::bf16_t*)(a.ws + WS_VTS),
                      a.out + OUT_CK, a.out + OUT_CV, (const f32x2*)(a.ws + WS_ROPE)};
        GEMM_PHASE(pg8::EpiQkv, E, WS_H, WS_WQKV, 6144, 2048); } SEAM(10);
    if (IN(11)) { p_attn(a, lds, bid, G); } SEAM(11);
    if (IN(12)) { GEMM_SPLIT2(WS_OA, WS_WOC, 2048); } SEAM(12);
    if (IN(13)) { p_ln(a, bid, G, false, MOD + 3 * 12288 + 2 * 2048, a.in[I_LNG] + 2 * 2048, a.in[I_LNB] + 2 * 2048, MOD + 3 * 12288 + 3 * 2048); } SEAM(13);
    if (IN(14)) { pg8::EpiPlain<1> E{(pg8::bf16_t*)(a.ws + WS_A2), 8192}; GEMM_PHASE(pg8::EpiPlain<1>, E, WS_H, WS_WF1 + (size_t)2048 * 8192 * 2, 8192, 2048); } SEAM(14);
    if (IN(15)) { GEMM_SPLIT2(WS_A2, WS_WF2 + (size_t)2048 * 8192 * 2, 8192); } SEAM(15);
    if (IN(16)) { p_ln(a, bid, G, false, MOD + 3 * 12288 + 5 * 2048, a.in[I_LNG] + 3 * 2048, a.in[I_LNB] + 3 * 2048, nullptr); }
#undef IN
#undef SEAM
#undef GEMM_PHASE
#undef GEMM_SPLIT2
}


#if MK_DIAG
constexpr size_t WS_DIAG = 640 * 1024;
constexpr size_t WS_YSAVE = WS_END;
__device__ __forceinline__ float bf2f(bf16 b) { return __uint_as_float((unsigned)b << 16); }
__device__ __forceinline__ void dmax(float* d, int i, float mine, float ref) { float e = fabsf(mine - ref) / (fabsf(ref) + 0.25f); if (!(e == e)) e = 1e9f; atomicMax((unsigned*)(d + i), __float_as_uint(e)); }
__device__ __forceinline__ float dot_bf(const bf16* arow, int K, const float* W, int ldw, int col) { float s = 0.f; for (int k = 0; k < K; ++k) s += bf2f(arow[k]) * W[(size_t)k * ldw + col]; return s; }
__device__ __forceinline__ int prow(int i) { const int j = i & 7; const int e = j == 0 ? 0 : j == 1 ? 255 : j == 2 ? 256 : j == 3 ? 8191 : j == 4 ? 8192 : j == 5 ? 10239 : j == 6 ? 10240 : 12287; return (i & 8) ? (int)(((unsigned)i * 977u + 13u) % 12288u) : e; }
__global__ void chk_zero(Args a) { ((float*)(a.ws + WS_DIAG))[threadIdx.x] = 0.f; }
__global__ void chk0(Args a) { float* dg = (float*)(a.ws + WS_DIAG); const int i = blockIdx.x * blockDim.x + threadIdx.x; if (i >= 96) return;
    const float* MOD = (const float*)(a.ws + WS_MOD);
    { const int l = i % 2, grp = (i / 2) % 3, col = (int)(((unsigned)i * 131u + 7u) % 12288u); float s = 0.f;
      for (int k = 0; k < 2048; ++k) { const float x = grp == 0 ? a.in[I_CCTX][k] : a.in[I_C][(grp - 1) * 2048 + k]; s += x / (1.f + expf(-x)) * a.in[I_WMOD][((size_t)l * 2048 + k) * 12288 + col]; }
      dmax(dg, 0, MOD[(size_t)(l * 3 + grp) * 12288 + col], s + a.in[I_BMOD][l * 12288 + col]); }
    { const int k = (i * 37) % 2048, n = (int)(((unsigned)i * 131u + 7u) % 3072u); int d = n; if (n < 1024) d = (n >> 7) * 256 + (n & 127); else if (n < 2048) { const int n1 = n - 1024; d = (n1 >> 7) * 256 + 128 + (n1 & 127); }
      dmax(dg, 1, bf2f(((const bf16*)(a.ws + WS_WIN))[(size_t)d * 2048 + k]), a.in[I_WIN][(size_t)k * 3072 + n]); }
    { const int k = (i * 83) % 8192, n = (i * 131 + 7) % 2048; dmax(dg, 2, bf2f(((const bf16*)(a.ws + WS_WF2))[(size_t)2048 * 8192 + (size_t)n * 8192 + k]), a.in[I_WF2][(size_t)2048 * 8192 + (size_t)k * 2048 + n]);
      const int k2 = (i * 37) % 2048; dmax(dg, 2, bf2f(((const bf16*)(a.ws + WS_WF1))[(size_t)2048 * 8192 + (size_t)(n * 4 + 1) * 2048 + k2]), a.in[I_WF1][(size_t)2048 * 8192 + (size_t)k2 * 8192 + n * 4 + 1]);
      dmax(dg, 2, bf2f(((const bf16*)(a.ws + WS_WQKV))[(size_t)(n * 3) * 2048 + k2]), a.in[I_WQKV][(size_t)k2 * 6144 + n * 3]);
      dmax(dg, 2, bf2f(((const bf16*)(a.ws + WS_WOC))[(size_t)n * 2048 + k2]), a.in[I_WOC][(size_t)k2 * 2048 + n] * a.in[I_SUBG][k2 & 127] * (1.f - (0.8f - 0.6f * expf(-0.3f))));
      dmax(dg, 18, bf2f(((const bf16*)(a.ws + WS_WF1))[(size_t)(n * 4 + 1) * 2048 + k2]), a.in[I_WF1][(size_t)k2 * 8192 + n * 4 + 1]);
      dmax(dg, 19, bf2f(((const bf16*)(a.ws + WS_WF2))[(size_t)n * 8192 + k]), a.in[I_WF2][(size_t)k * 2048 + n]);
      dmax(dg, 2, bf2f(((const bf16*)(a.ws + WS_WGLU))[(size_t)(n & 1023) * 1024 + (k2 & 1023)]), a.in[I_WGLU][(size_t)(k2 & 1023) * 1024 + (n & 1023)]);
      dmax(dg, 2, bf2f(((const bf16*)(a.ws + WS_WOAB))[(size_t)n * 2048 + k2]), a.in[I_WOAB][(size_t)k2 * 2048 + n]); }
}
__global__ void chk_in(Args a) { float* dg = (float*)(a.ws + WS_DIAG); const int i = blockIdx.x * blockDim.x + threadIdx.x; if (i >= 64) return;
    const int row = prow(i), c = (int)(((unsigned)i * 131u + 7u) % 1024u); const bf16* h = (const bf16*)(a.ws + WS_H) + (size_t)row * 2048;
    const float val = dot_bf(h, 2048, a.in[I_WIN], 3072, c), gate = dot_bf(h, 2048, a.in[I_WIN], 3072, 1024 + c), u = dot_bf(h, 2048, a.in[I_WIN], 3072, 2048 + c);
    dmax(dg, 3, bf2f(((const bf16*)(a.ws + WS_UG))[(size_t)row * 1024 + c]), val / (1.f + expf(-gate))); dmax(dg, 4, bf2f(((const bf16*)(a.ws + WS_US))[(size_t)row * 1024 + c]), u);
    { const int cc = (i * 131 + 7) % 2048; const float* x = row < TP ? a.in[I_XP] + (size_t)row * DM : a.in[I_XS] + (size_t)(row - TP) * DM; const float* md = (const float*)(a.ws + WS_MOD) + (size_t)row_grp(row) * 12288;
      dmax(dg, 5, bf2f(h[cc]), x[cc] * (1.f + md[2048 + cc]) + md[cc]); }
}
__global__ void chk_s5(Args a) { float* dg = (float*)(a.ws + WS_DIAG); const int i = threadIdx.x; if (i >= 4) return;
    const bool sample = i >= 2; const int dir = i & 1, b = sample ? 1 : 3, g = sample ? 7 : 5, L = sample ? 2048 : 256, row0 = sample ? TP + b * 2048 : b * 256;
    const bf16* US = (const bf16*)(a.ws + WS_US); const float* Yo = (const float*)(a.ws + (dir ? WS_YR : WS_YF)); const int pg = (dir * 64 + g) * 64; const float dt = expf(a.in[I_LDT][dir * 64 + g]);
    float* hr = (float*)(a.ws + WS_YSAVE + 65536) + i * 256; float* hi = hr + 64; float* y = hr + 128;
    for (int n = 0; n < 64; ++n) { hr[n] = 0.f; hi[n] = 0.f; if (sample) { const size_t o = (size_t)((b * 2 + dir) * 64 + g) * 64 + n; hr[n] = a.in[I_SRE][o]; hi[n] = a.in[I_SIM][o]; } }
    for (int t = 0; t < L; ++t) { const int tk = dir ? L - 1 - t : t; for (int p = 0; p < 16; ++p) y[p] = 0.f;
        for (int n = 0; n < 64; ++n) { const float lre = a.in[I_LRE][pg + n], lim = a.in[I_LIM][pg + n], mag = expf(lre * dt), br = mag * cosf(lim * dt), bi = mag * sinf(lim * dt), den = lre * lre + lim * lim;
            const float cr = ((br - 1.f) * lre + bi * lim) / den, ci = (bi * lre - (br - 1.f) * lim) / den; float bur = 0.f, bui = 0.f;
            for (int p = 0; p < 16; ++p) { const float u = bf2f(US[(size_t)(row0 + tk) * 1024 + g * 16 + p]); const float b_r = a.in[I_BRE][(size_t)(pg + n) * 16 + p], b_i = a.in[I_BIM][(size_t)(pg + n) * 16 + p]; bur += u * (cr * b_r - ci * b_i); bui += u * (cr * b_i + ci * b_r); }
            const float nr = br * hr[n] - bi * hi[n] + bur, ni = br * hi[n] + bi * hr[n] + bui; hr[n] = nr; hi[n] = ni;
            for (int p = 0; p < 16; ++p) y[p] += a.in[I_CRE][(size_t)((dir * 64 + g) * 16 + p) * 64 + n] * nr - a.in[I_CIM][(size_t)((dir * 64 + g) * 16 + p) * 64 + n] * ni; }
        for (int p = 0; p < 16; ++p) dmax(dg, 6 + (sample ? 1 : 0), Yo[(size_t)(row0 + tk) * 1024 + g * 16 + p], y[p]); }
    if (!sample) for (int n = 0; n < 64; ++n) { const size_t o = (size_t)((b * 2 + dir) * 64 + g) * 64 + n; dmax(dg, 8, a.out[OUT_SRE + o], hr[n]); dmax(dg, 8, a.out[OUT_SIM + o], hi[n]); }
}
__global__ void chk_ys(Args a) { float* dg = (float*)(a.ws + WS_DIAG); const int i = blockIdx.x * blockDim.x + threadIdx.x; if (i >= 64) return;
    const int row = prow(i), c = (int)(((unsigned)i * 131u + 7u) % 1024u); const size_t o = (size_t)row * 1024 + c;
    const float x = ((const float*)(a.ws + WS_YF))[o] + ((const float*)(a.ws + WS_YR))[o] + a.in[I_S5D][c] * bf2f(((const bf16*)(a.ws + WS_US))[o]);
    const float ge = 0.5f * x * (1.f + tanhf(0.7978845608f * (x + 0.044715f * x * x * x))); dmax(dg, 9, bf2f(((const bf16*)(a.ws + WS_YS))[o]), ge);
}
__global__ void chk_conv(Args a) { float* dg = (float*)(a.ws + WS_DIAG); __shared__ float red[1024]; const int c = threadIdx.x, row = prow(blockIdx.x); int s0, s1;
    if (row < TP) { s0 = row & ~255; s1 = s0 + 256; } else { s0 = TP + ((row - TP) & ~2047); s1 = s0 + 2048; }
    float acc = a.in[I_BDW][c]; for (int k = 0; k < 31; ++k) { const int r = row + k - 15; if (r >= s0 && r < s1) acc += a.in[I_WDW][k * 1024 + c] * bf2f(((const bf16*)(a.ws + WS_UG))[(size_t)r * 1024 + c]); }
    red[c] = acc; __syncthreads(); float m = 0.f; for (int j = 0; j < 1024; ++j) m += red[j]; m /= 1024.f; float v = 0.f; for (int j = 0; j < 1024; ++j) v += (red[j] - m) * (red[j] - m); v /= 1024.f;
    float y = (acc - m) / sqrtf(v + LN_EPS) * a.in[I_CLNG][c] + a.in[I_CLNB][c]; y = y / (1.f + expf(-y)); dmax(dg, 10, bf2f(((const bf16*)(a.ws + WS_CAT))[(size_t)row * 2048 + c]), y);
}
__global__ void chk_glu(Args a) { float* dg = (float*)(a.ws + WS_DIAG); const int i = blockIdx.x * blockDim.x + threadIdx.x; if (i >= 64) return;
    const int row = prow(i), c = (int)(((unsigned)i * 131u + 7u) % 1024u); const bf16* ys = (const bf16*)(a.ws + WS_YS) + (size_t)row * 1024; const float g = dot_bf(ys, 1024, a.in[I_WGLU], 1024, c);
    dmax(dg, 11, bf2f(((const bf16*)(a.ws + WS_CAT))[(size_t)row * 2048 + 1024 + c]), bf2f(ys[c]) / (1.f + expf(-g)));
}
__global__ void chk_proj(Args a, size_t aoff, int K, const float* W, int slot, int scaled) { float* dg = (float*)(a.ws + WS_DIAG); const int i = blockIdx.x * blockDim.x + threadIdx.x; if (i >= 64) return;
    const int row = prow(i), c = (int)(((unsigned)i * 131u + 7u) % 2048u); const bf16* ar = (const bf16*)(a.ws + aoff) + (size_t)row * K; float s = 0.f;
    for (int k = 0; k < K; ++k) { float w = W[(size_t)k * 2048 + c]; if (scaled) w *= a.in[I_SUBG][k & 127] * (1.f - (0.8f - 0.6f * expf(-0.3f))); s += bf2f(ar[k]) * w; }
    dmax(dg, slot, bf2f(((const bf16*)(a.ws + WS_F))[(size_t)row * 2048 + c]), s);
}
__global__ void chk_ff1(Args a, const float* W, int slot) { float* dg = (float*)(a.ws + WS_DIAG); const int i = blockIdx.x * blockDim.x + threadIdx.x; if (i >= 64) return;
    const int row = prow(i), c = (int)(((unsigned)i * 131u + 7u) % 8192u); const bf16* h = (const bf16*)(a.ws + WS_H) + (size_t)row * 2048; float s = fmaxf(dot_bf(h, 2048, W, 8192, c), 0.f);
    dmax(dg, slot == 14 ? 33 + (i & 7) : slot, bf2f(((const bf16*)(a.ws + WS_A2))[(size_t)row * 8192 + c]), s * s);
    if (slot == 14) { const int k2 = (i * 37) % 2048; dmax(dg, 32, bf2f(((const bf16*)(a.ws + WS_WF1))[(size_t)c * 2048 + k2]), W[(size_t)k2 * 8192 + c]); }
}
__global__ void chk_save(Args a) { const int r = blockIdx.x; for (int c = threadIdx.x; c < 2048; c += blockDim.x) ((float*)(a.ws + WS_YSAVE))[r * 2048 + c] = a.out[OUT_Y + (size_t)prow(r) * 2048 + c]; }
__global__ void chk_ln(Args a, int first, int l, int which, int slot) { float* dg = (float*)(a.ws + WS_DIAG); __shared__ float red[2048]; const int r = blockIdx.x, row = prow(r), grp = row_grp(row);
    const float* MOD = (const float*)(a.ws + WS_MOD) + (size_t)(l * 3 + grp) * 12288; const float* x = first ? (row < TP ? a.in[I_XP] + (size_t)row * DM : a.in[I_XS] + (size_t)(row - TP) * DM) : (const float*)(a.ws + WS_YSAVE) + r * 2048;
    for (int c = threadIdx.x; c < 2048; c += blockDim.x) red[c] = ALPHA * x[c] + MOD[(which ? 5 : 2) * 2048 + c] * bf2f(((const bf16*)(a.ws + WS_F))[(size_t)row * 2048 + c]);
    __syncthreads(); float m = 0.f; for (int j = 0; j < 2048; ++j) m += red[j]; m /= 2048.f; float v = 0.f; for (int j = 0; j < 2048; ++j) v += (red[j] - m) * (red[j] - m); v /= 2048.f;
    for (int c = threadIdx.x; c < 2048; c += blockDim.x) { const float y = (red[c] - m) / sqrtf(v + LN_EPS) * a.in[I_LNG][(l * 2 + which) * 2048 + c] + a.in[I_LNB][(l * 2 + which) * 2048 + c];
        dmax(dg, slot, a.out[OUT_Y + (size_t)row * 2048 + c], y);
        if (!(l == 1 && which == 1)) { const float* nm = which ? (const float*)(a.ws + WS_MOD) + (size_t)((l + 1) * 3 + grp) * 12288 : MOD + 3 * 2048; dmax(dg, slot, bf2f(((const bf16*)(a.ws + WS_H))[(size_t)row * 2048 + c]), y * (1.f + nm[2048 + c]) + nm[c]); } }
}
__global__ void chk_qkv(Args a) { float* dg = (float*)(a.ws + WS_DIAG); const int i = blockIdx.x * blockDim.x + threadIdx.x; if (i >= 64) return;
    const int row = prow(i); const bool sample = row >= TP; const int s = sample ? (row - TP) & 2047 : row & 255, bb = sample ? (row - TP) >> 11 : row >> 8; const bf16* h = (const bf16*)(a.ws + WS_H) + (size_t)row * 2048;
    const int col = (int)(((unsigned)i * 131u + 7u) % 2048u), mm = col >> 10, hh = (col >> 6) & 15, d = col & 63;
    for (int which = 0; which < 2; ++which) { float v = dot_bf(h, 2048, a.in[I_WQKV], 6144, which * 2048 + col);
        if (sample) { const int seg = d >> 5, ii = d & 15, second = (d >> 4) & 1; const float pos = seg ? (float)(s & 63) : (float)(s >> 6); const float ang = pos * powf(10000.f, -(float)ii / 16.f);
            const float other = dot_bf(h, 2048, a.in[I_WQKV], 6144, which * 2048 + (second ? col - 16 : col + 16)); v = second ? other * sinf(ang) + v * cosf(ang) : v * cosf(ang) - other * sinf(ang); }
        if (which == 0) dmax(dg, 20, bf2f(((const bf16*)(a.ws + WS_QB))[(size_t)row * 2048 + col]), v * QSCALE);
        else if (sample) dmax(dg, 21, bf2f(((const bf16*)(a.ws + WS_KS))[((size_t)((bb * 2 + mm) * 16 + hh) * 2560 + s) * 64 + d]), v);
        else { const size_t o = ((size_t)((bb * 2 + mm) * 16 + hh) * 256 + s) * 64 + d; dmax(dg, 21, bf2f(((const bf16*)(a.ws + WS_KP))[o]), v); dmax(dg, 22, a.out[OUT_CK + o], v); } }
    { const int hv = col >> 7, dv = col & 127; const float v = dot_bf(h, 2048, a.in[I_WQKV], 6144, 4096 + col);
      if (sample) dmax(dg, 23, bf2f(((const bf16*)(a.ws + WS_VTS))[((size_t)(bb * 16 + hv) * 128 + dv) * 2560 + s]), v);
      else { dmax(dg, 23, bf2f(((const bf16*)(a.ws + WS_VTP))[((size_t)(bb * 16 + hv) * 128 + dv) * 256 + s]), v); dmax(dg, 24, a.out[OUT_CV + ((size_t)(bb * 16 + hv) * 256 + s) * 128 + dv], v); } }
    { const int bmh = i, j = (i * 37) % 512, dd = (i * 11) % 64; dmax(dg, 25, bf2f(((const bf16*)(a.ws + WS_KS))[((size_t)bmh * 2560 + 2048 + j) * 64 + dd]), a.in[I_CK][((size_t)bmh * 512 + j) * 64 + dd]);
      const int bh = i & 31, dv2 = (i * 29) % 128; dmax(dg, 25, bf2f(((const bf16*)(a.ws + WS_VTS))[((size_t)bh * 128 + dv2) * 2560 + 2048 + j]), a.in[I_CV][((size_t)bh * 512 + j) * 128 + dv2]); }
}
__global__ void chk_attn(Args a) { float* dg = (float*)(a.ws + WS_DIAG); const int i = blockIdx.x * blockDim.x + threadIdx.x; if (i >= 32) return;
    const int row = prow(i), hh = (i * 5) % 16; const bool sample = row >= TP; const int bb = sample ? (row - TP) >> 11 : row >> 8, nk = sample ? 2560 : 256;
    const bf16* q = (const bf16*)(a.ws + WS_QB) + (size_t)row * 2048 + hh * 64; float* o = (float*)(a.ws + WS_YSAVE + 65536 + 8192) + i * 128; for (int d = 0; d < 128; ++d) o[d] = 0.f;
    float d1 = 0.f, d2 = 0.f; for (int j = 0; j < 64; ++j) { d1 += a.in[I_LQ1][j] * a.in[I_LK1][j]; d2 += a.in[I_LQ2][j] * a.in[I_LK2][j]; } const float lam = expf(d1) - expf(d2) + 0.8f - 0.6f * expf(-0.3f);
    const bf16* VT = sample ? (const bf16*)(a.ws + WS_VTS) + (size_t)(bb * 16 + hh) * 128 * 2560 : (const bf16*)(a.ws + WS_VTP) + (size_t)(bb * 16 + hh) * 128 * 256;
    for (int m = 0; m < 2; ++m) { const bf16* K = sample ? (const bf16*)(a.ws + WS_KS) + (size_t)((bb * 2 + m) * 16 + hh) * 2560 * 64 : (const bf16*)(a.ws + WS_KP) + (size_t)((bb * 2 + m) * 16 + hh) * 256 * 64;
        float mx = -1e30f; for (int k = 0; k < nk; ++k) { float s = 0.f; for (int d = 0; d < 64; ++d) s += bf2f(q[m * 1024 + d]) * bf2f(K[(size_t)k * 64 + d]); mx = fmaxf(mx, s); }
        float l = 0.f; for (int k = 0; k < nk; ++k) { float s = 0.f; for (int d = 0; d < 64; ++d) s += bf2f(q[m * 1024 + d]) * bf2f(K[(size_t)k * 64 + d]); l += exp2f(s - mx); }
        for (int k = 0; k < nk; ++k) { float s = 0.f; for (int d = 0; d < 64; ++d) s += bf2f(q[m * 1024 + d]) * bf2f(K[(size_t)k * 64 + d]); const float p = exp2f(s - mx) / l * (m ? -lam : 1.f);
            for (int d = 0; d < 128; ++d) o[d] += p * bf2f(VT[(size_t)d * nk + k]); } }
    float ss = 0.f; for (int d = 0; d < 128; ++d) ss += o[d] * o[d]; const float ri = 1.f / sqrtf(ss / 128.f + LN_EPS);
    for (int d = 0; d < 128; ++d) dmax(dg, 26, bf2f(((const bf16*)(a.ws + WS_OA))[(size_t)row * 2048 + hh * 128 + d]), o[d] * ri);
}
__global__ void chk_report(Args a) { const float* dg = (const float*)(a.ws + WS_DIAG); if (threadIdx.x == 0 && blockIdx.x == 0) { for (int i = 0; i < 48; ++i) if (dg[i] > 0.04f) { a.out[0] = 100.f * (float)(i + 1); break; } } }
#endif

#if MK_DET
#ifndef DET_PH
#define DET_PH 17
#endif
__global__ void det_sum(const unsigned* A, size_t n, unsigned long long* res) { size_t i = (size_t)blockIdx.x * blockDim.x + threadIdx.x; unsigned long long s = 0;
    for (; i < n; i += (size_t)gridDim.x * blockDim.x) s += (unsigned long long)A[i] * (unsigned long long)((i & 1023) + 1);
    atomicAdd(res, s); }
__global__ void det_zero(unsigned long long* res) { res[threadIdx.x] = 0ull; }
__global__ void det_rep(float* out, const unsigned long long* res) { if (res[0] != res[1]) out[0] = 1000.f; }
#endif
extern "C" void kernel_launch(void* const* d_in, const int* in_sizes, int n_in, void* d_out, int out_size, void* d_ws, size_t ws_size, hipStream_t stream) {
    static int grid = 0;
    if (grid == 0) {
        if (n_in != 36 || ws_size < WS_END) { fprintf(stderr, "kernel_launch: unexpected n_in %d / ws_size %zu\n", n_in, ws_size); grid = -1; return; }
        int dev = 0, cus = 0, per_cu = 0;
        if (hipGetDevice(&dev) != hipSuccess || hipDeviceGetAttribute(&cus, hipDeviceAttributeMultiprocessorCount, dev) != hipSuccess) { grid = -1; return; }
        if (hipFuncSetAttribute((const void*)fwd_mega, hipFuncAttributeMaxDynamicSharedMemorySize, LDS_BYTES) != hipSuccess) { fprintf(stderr, "kernel_launch: hipFuncSetAttribute failed\n"); grid = -1; return; }
        if (hipOccupancyMaxActiveBlocksPerMultiprocessor(&per_cu, (const void*)fwd_mega, NTHR, LDS_BYTES) != hipSuccess || per_cu < 1) { fprintf(stderr, "kernel_launch: occupancy query says %d\n", per_cu); per_cu = 1; }
        (void)hipGetLastError();
        grid = cus * 1;
    }
    if (grid < 0) return;
    if (hipMemsetAsync((char*)d_ws + WS_BAR, 0, XCD_BAR_WORDS * 4, stream) != hipSuccess) { fprintf(stderr, "kernel_launch: memset of barrier words failed\n"); return; }
    Args a{};
    for (int i = 0; i < 36; ++i) a.in[i] = (const float*)d_in[i];
    a.out = (float*)d_out; a.ws = (unsigned char*)d_ws;
#if MK_MULTI
#if MK_DIAG
    {  void* ca[] = {&a}; hipLaunchCooperativeKernel((const void*)chk_zero, dim3(1), dim3(64), ca, 0, stream); }
#endif
    for (int ph = 0; ph < NPHASE; ++ph) { a.ph_lo = ph; a.ph_hi = ph + 1; void* args[] = {&a};
#if MK_DIAG
        if (ph == 9 || ph == 13 || ph == 16) {  void* ca[] = {&a}; hipLaunchCooperativeKernel((const void*)chk_save, dim3(8), dim3(256), ca, 0, stream); }
#endif
        hipError_t e = hipLaunchCooperativeKernel((const void*)fwd_mega, dim3(grid), dim3(NTHR), args, LDS_BYTES, stream);
        if (e != hipSuccess) { fprintf(stderr, "launch %d failed: %s\n", ph, hipGetErrorString(e)); break; }
#if MK_DIAG
        const float* in_[36]; for (int i = 0; i < 36; ++i) in_[i] = (const float*)d_in[i];
        if (ph == 0) {  void* ca[] = {&a}; hipLaunchCooperativeKernel((const void*)chk0, dim3(1), dim3(128), ca, 0, stream); }
        if (ph == 2) {  void* ca[] = {&a}; hipLaunchCooperativeKernel((const void*)chk_in, dim3(1), dim3(64), ca, 0, stream); }
        if (ph == 3) { {  void* ca[] = {&a}; hipLaunchCooperativeKernel((const void*)chk_s5, dim3(1), dim3(64), ca, 0, stream); } {  void* ca[] = {&a}; hipLaunchCooperativeKernel((const void*)chk_ys, dim3(1), dim3(64), ca, 0, stream); } {  void* ca[] = {&a}; hipLaunchCooperativeKernel((const void*)chk_conv, dim3(16), dim3(1024), ca, 0, stream); } }
        if (ph == 4) {  void* ca[] = {&a}; hipLaunchCooperativeKernel((const void*)chk_glu, dim3(1), dim3(64), ca, 0, stream); }
        if (ph == 5) { auto v1 = WS_CAT; auto v2 = 2048; auto v3 = in_[I_WOAB]; auto v4 = 12; auto v5 = 0; void* ca[] = {&a, &v1, &v2, &v3, &v4, &v5}; hipLaunchCooperativeKernel((const void*)chk_proj, dim3(1), dim3(64), ca, 0, stream); }
        if (ph == 6) { auto v1 = 1; auto v2 = 0; auto v3 = 0; auto v4 = 13; void* ca[] = {&a, &v1, &v2, &v3, &v4}; hipLaunchCooperativeKernel((const void*)chk_ln, dim3(8), dim3(256), ca, 0, stream); }
        if (ph == 7) { auto v1 = in_[I_WF1]; auto v2 = 14; void* ca[] = {&a, &v1, &v2}; hipLaunchCooperativeKernel((const void*)chk_ff1, dim3(1), dim3(64), ca, 0, stream); }
        if (ph == 8) { auto v1 = WS_A2; auto v2 = 8192; auto v3 = in_[I_WF2]; auto v4 = 15; auto v5 = 0; void* ca[] = {&a, &v1, &v2, &v3, &v4, &v5}; hipLaunchCooperativeKernel((const void*)chk_proj, dim3(1), dim3(64), ca, 0, stream); }
        if (ph == 9) { auto v1 = 0; auto v2 = 0; auto v3 = 1; auto v4 = 16; void* ca[] = {&a, &v1, &v2, &v3, &v4}; hipLaunchCooperativeKernel((const void*)chk_ln, dim3(8), dim3(256), ca, 0, stream); }
        if (ph == 10) {  void* ca[] = {&a}; hipLaunchCooperativeKernel((const void*)chk_qkv, dim3(1), dim3(64), ca, 0, stream); }
        if (ph == 11) {  void* ca[] = {&a}; hipLaunchCooperativeKernel((const void*)chk_attn, dim3(1), dim3(64), ca, 0, stream); }
        if (ph == 12) { auto v1 = WS_OA; auto v2 = 2048; auto v3 = in_[I_WOC]; auto v4 = 27; auto v5 = 1; void* ca[] = {&a, &v1, &v2, &v3, &v4, &v5}; hipLaunchCooperativeKernel((const void*)chk_proj, dim3(1), dim3(64), ca, 0, stream); }
        if (ph == 13) { auto v1 = 0; auto v2 = 1; auto v3 = 0; auto v4 = 28; void* ca[] = {&a, &v1, &v2, &v3, &v4}; hipLaunchCooperativeKernel((const void*)chk_ln, dim3(8), dim3(256), ca, 0, stream); }
        if (ph == 14) { auto v1 = in_[I_WF1] + (size_t)2048 * 8192; auto v2 = 29; void* ca[] = {&a, &v1, &v2}; hipLaunchCooperativeKernel((const void*)chk_ff1, dim3(1), dim3(64), ca, 0, stream); }
        if (ph == 15) { auto v1 = WS_A2; auto v2 = 8192; auto v3 = in_[I_WF2] + (size_t)2048 * 8192; auto v4 = 30; auto v5 = 0; void* ca[] = {&a, &v1, &v2, &v3, &v4, &v5}; hipLaunchCooperativeKernel((const void*)chk_proj, dim3(1), dim3(64), ca, 0, stream); }
        if (ph == 16) { { auto v1 = 0; auto v2 = 1; auto v3 = 1; auto v4 = 31; void* ca[] = {&a, &v1, &v2, &v3, &v4}; hipLaunchCooperativeKernel((const void*)chk_ln, dim3(8), dim3(256), ca, 0, stream); } {  void* ca[] = {&a}; hipLaunchCooperativeKernel((const void*)chk_report, dim3(1), dim3(64), ca, 0, stream); } }
#endif
    }
#else
    a.ph_lo = 0; a.ph_hi = NPHASE; void* args[] = {&a};
#if MK_DET
    { unsigned long long* res = (unsigned long long*)((char*)d_ws + 768 * 1024); a.ph_hi = DET_PH;
      { void* c0[] = {&res}; hipLaunchCooperativeKernel((const void*)det_zero, dim3(1), dim3(8), c0, 0, stream); }
      for (int rep = 0; rep < 2; ++rep) {
        a.ph_lo = 0; a.ph_hi = DET_PH; hipLaunchCooperativeKernel((const void*)fwd_mega, dim3(grid), dim3(NTHR), args, LDS_BYTES, stream);
        unsigned long long* r = res + rep;
        { const unsigned* p = (const unsigned*)d_ws; size_t n = (640 * 1024) / 4; void* c1[] = {&p, &n, &r}; hipLaunchCooperativeKernel((const void*)det_sum, dim3(64), dim3(256), c1, 0, stream); }
        { const unsigned* p = (const unsigned*)((char*)d_ws + DET_LO); size_t n = (DET_HI - DET_LO) / 4; void* c1[] = {&p, &n, &r}; hipLaunchCooperativeKernel((const void*)det_sum, dim3(2048), dim3(256), c1, 0, stream); }
        if (!DET_NO_OUT) { const unsigned* p = (const unsigned*)d_out; size_t n = (size_t)out_size; void* c1[] = {&p, &n, &r}; hipLaunchCooperativeKernel((const void*)det_sum, dim3(2048), dim3(256), c1, 0, stream); }
      }
      { float* po = (float*)d_out; const unsigned long long* pr = res; void* c2[] = {&po, &pr}; hipLaunchCooperativeKernel((const void*)det_rep, dim3(1), dim3(1), c2, 0, stream); }
      return; }
#endif
    hipError_t e = hipLaunchCooperativeKernel((const void*)fwd_mega, dim3(grid), dim3(NTHR), args, LDS_BYTES, stream);
    if (e != hipSuccess) fprintf(stderr, "cooperative launch failed: %s (grid %d)\n", hipGetErrorString(e), grid);
#endif
}
```
